# Optimizing an MI355X kernel written in HIP

```python
import math
import jax, jax.numpy as jnp
from jax import lax
import numpy as np


D_MODEL = 1024
BATCH = 4
SEQ = 4096
DEPTH = 2

GRID_W = 64
CTX_LEN = 256
N_DIFF_HEADS = 6
DIFF_HEAD_DIM = 64
DIFF_V_DIM = 2 * DIFF_HEAD_DIM
N_FOURIER_GROUPS = 4
FOURIER_GROUP_DIM = 64
ATTN_QK_W = N_DIFF_HEADS * 2 * DIFF_HEAD_DIM
ATTN_V_W = N_DIFF_HEADS * DIFF_V_DIM
FOURIER_W = N_FOURIER_GROUPS * FOURIER_GROUP_DIM
EVEN_IN_W = 2 * ATTN_QK_W + ATTN_V_W + FOURIER_W
EVEN_MIX_W = ATTN_V_W + FOURIER_W
CONV_K = 3
N_EXPERTS = 16
EC_CAPACITY_FACTOR = 2
D_EXPERT = 1024
ROPE_BASE = 10000.0
Q_BLOCK = 128
EPS = 1e-6
N_EVEN = (DEPTH + 1) // 2
N_ODD = DEPTH // 2

kernel_name = 'hybrid_diffattn_fourier_shortconv_ecmoe_dit'


def rmsnorm(x, g):
    xf = x.astype(jnp.float32)
    y = xf * lax.rsqrt(jnp.mean(xf * xf, axis=-1, keepdims=True) + EPS)
    return (y * g.astype(jnp.float32)).astype(x.dtype)


def modulate(x, g, shift, scale):
    return rmsnorm(x, g) * (1 + scale) + shift


def ada_params(cond, w_ada, b_ada):
    m = jax.nn.silu(cond) @ w_ada + b_ada
    return jnp.split(m[..., None, :], 6, axis=-1)


def axial_rope(n, dtype):
    rows = n // GRID_W
    r = jnp.repeat(jnp.arange(rows, dtype=jnp.float32), GRID_W)
    col = jnp.tile(jnp.arange(GRID_W, dtype=jnp.float32), rows)
    n_freq = DIFF_HEAD_DIM // 4
    inv = ROPE_BASE ** (-jnp.arange(n_freq, dtype=jnp.float32) / n_freq)
    ar = r[:, None] * inv
    ac = col[:, None] * inv
    ang = jnp.concatenate([ar, ar, ac, ac], axis=-1)
    return jnp.cos(ang).astype(dtype), jnp.sin(ang).astype(dtype)


def apply_rope(x, cos, sin):
    x1, x2, x3, x4 = jnp.split(x, 4, axis=-1)
    rot = jnp.concatenate([-x2, x1, -x4, x3], axis=-1)
    return x * cos[None, :, None, None, :] + rot * sin[None, :, None, None, :]


def qk_heads(t):
    return t.reshape(t.shape[0], t.shape[1], N_DIFF_HEADS, 2, DIFF_HEAD_DIM)


def v_heads(t):
    return t.reshape(t.shape[0], t.shape[1], N_DIFF_HEADS, DIFF_V_DIM)


def diff_attend(q, k, v, lam):
    s = jnp.einsum('bqhmd,bkhmd->bhmqk', q, k).astype(jnp.float32)
    p = jax.nn.softmax(s, axis=-1)
    a = p[:, :, 0] - lam * p[:, :, 1]
    return jnp.einsum('bhqk,bkhe->bqhe', a.astype(v.dtype), v)


def blocked_diff_attend(q, k, v, lam):
    b, n = q.shape[0], q.shape[1]
    qb = q.reshape(b, n // Q_BLOCK, Q_BLOCK, N_DIFF_HEADS, 2, DIFF_HEAD_DIM).swapaxes(0, 1)
    out = lax.map(lambda qq: diff_attend(qq, k, v, lam), qb)
    return out.swapaxes(0, 1).reshape(b, n, N_DIFF_HEADS, DIFF_V_DIM)


def fourier_mix(f):
    b, n = f.shape[0], f.shape[1]
    fg = f.reshape(b, n, N_FOURIER_GROUPS, FOURIER_GROUP_DIM).astype(jnp.float32)
    y = jnp.fft.fft2(fg, axes=(1, 3), norm='ortho').real
    return y.reshape(b, n, FOURIER_W).astype(f.dtype)


def merge_even(att, f, subln, lam_init, w_out):
    b, n = att.shape[0], att.shape[1]
    att = rmsnorm(att, subln) * (1.0 - lam_init)
    o = jnp.concatenate([att.reshape(b, n, ATTN_V_W), fourier_mix(f)], axis=-1)
    return o @ w_out


def even_mixer(h, hc, w_in, q_norm, k_norm, lam, subln, w_out, lam_init, cos, sin, ctx_out):
    scale = DIFF_HEAD_DIM ** -0.5
    cuts = [ATTN_QK_W, 2 * ATTN_QK_W, 2 * ATTN_QK_W + ATTN_V_W]
    q, k, v, f = jnp.split(h @ w_in, cuts, axis=-1)
    q = apply_rope(rmsnorm(qk_heads(q), q_norm), cos, sin) * scale
    k = apply_rope(rmsnorm(qk_heads(k), k_norm), cos, sin)
    qc = None
    fc = None
    if ctx_out:
        qc, kc, vc, fc = jnp.split(hc @ w_in, cuts, axis=-1)
    else:
        kc, vc = jnp.split(hc @ w_in[:, ATTN_QK_W:2 * ATTN_QK_W + ATTN_V_W], [ATTN_QK_W], axis=-1)
    kc = rmsnorm(qk_heads(kc), k_norm)
    vc = v_heads(vc)
    keys = jnp.concatenate([k, kc], axis=1)
    vals = jnp.concatenate([v_heads(v), vc], axis=1)
    y = merge_even(blocked_diff_attend(q, keys, vals, lam), f, subln, lam_init, w_out)
    yc = None
    if ctx_out:
        qc = rmsnorm(qk_heads(qc), q_norm) * scale
        yc = merge_even(diff_attend(qc, kc, vc, lam), fc, subln, lam_init, w_out)
    return y, yc


def shortconv(z, w):
    zp = jnp.pad(z, ((0, 0), (1, 1), (0, 0)))
    return w[0] * zp[:, :-2] + w[1] * zp[:, 1:-1] + w[2] * zp[:, 2:]


def odd_mixer(h, w_in, conv_w, w_out):
    bg, cg, u = jnp.split(h @ w_in, 3, axis=-1)
    return (bg * shortconv(cg * u, conv_w)) @ w_out


def ec_moe(h, w_router, w_gate, w_up, w_down):
    b, n, d = h.shape
    cap = EC_CAPACITY_FACTOR * n // N_EXPERTS
    aff = jax.nn.softmax(h.astype(jnp.float32) @ w_router.astype(jnp.float32), axis=-1)
    g, idx = lax.top_k(aff.swapaxes(1, 2), cap)
    xs = jax.vmap(lambda hb, ib: hb[ib])(h, idx)
    a = jax.nn.silu(jnp.einsum('becd,edf->becf', xs, w_gate)) * jnp.einsum('becd,edf->becf', xs, w_up)
    y = jnp.einsum('becf,efd->becd', a, w_down) * g[..., None].astype(h.dtype)
    return jax.vmap(lambda yb, ib: jnp.zeros((n, d), yb.dtype).at[ib.reshape(-1)].add(yb.reshape(-1, d)))(y, idx)


def setup_inputs(seed: int = 0) -> dict:
    key = jax.random.key(seed)
    ks = jax.random.split(key, 24)

    def nrm(k, shape, s):
        return jax.random.normal(k, shape, jnp.float32) * s

    D = D_MODEL
    return {
        'x': nrm(ks[0], (BATCH, SEQ, D), 1.0),
        'c': nrm(ks[1], (BATCH, D), 1.0),
        'ctx': nrm(ks[2], (BATCH, CTX_LEN, D), 1.0),
        'c_ctx': nrm(ks[3], (D,), 1.0),
        'ada_w': nrm(ks[4], (DEPTH, D, 6 * D), 0.5 * D ** -0.5),
        'ada_b': nrm(ks[5], (DEPTH, 6 * D), 0.02),
        'norm_mix': 1.0 + nrm(ks[6], (DEPTH, D), 0.02),
        'norm_ffn': 1.0 + nrm(ks[7], (DEPTH, D), 0.02),
        'attn_w_in': nrm(ks[8], (N_EVEN, D, EVEN_IN_W), D ** -0.5),
        'attn_q_norm': 1.0 + nrm(ks[9], (N_EVEN, DIFF_HEAD_DIM), 0.02),
        'attn_k_norm': 1.0 + nrm(ks[10], (N_EVEN, DIFF_HEAD_DIM), 0.02),
        'lam_q1': nrm(ks[11], (N_EVEN, DIFF_HEAD_DIM), 0.1),
        'lam_k1': nrm(ks[12], (N_EVEN, DIFF_HEAD_DIM), 0.1),
        'lam_q2': nrm(ks[13], (N_EVEN, DIFF_HEAD_DIM), 0.1),
        'lam_k2': nrm(ks[14], (N_EVEN, DIFF_HEAD_DIM), 0.1),
        'attn_subln': 1.0 + nrm(ks[15], (N_EVEN, DIFF_V_DIM), 0.02),
        'attn_w_out': nrm(ks[16], (N_EVEN, EVEN_MIX_W, D), EVEN_MIX_W ** -0.5),
        'conv_w_in': nrm(ks[17], (N_ODD, D, 3 * D), D ** -0.5),
        'conv_w': nrm(ks[18], (N_ODD, CONV_K, D), CONV_K ** -0.5),
        'conv_w_out': nrm(ks[19], (N_ODD, D, D), D ** -0.5),
        'router_w': nrm(ks[20], (DEPTH, D, N_EXPERTS), D ** -0.5),
        'moe_w_gate': nrm(ks[21], (DEPTH, N_EXPERTS, D, D_EXPERT), D ** -0.5),
        'moe_w_up': nrm(ks[22], (DEPTH, N_EXPERTS, D, D_EXPERT), D ** -0.5),
        'moe_w_down': nrm(ks[23], (DEPTH, N_EXPERTS, D_EXPERT, D), D_EXPERT ** -0.5),
    }


def reference(x, c, ctx, c_ctx, ada_w, ada_b, norm_mix, norm_ffn,
              attn_w_in, attn_q_norm, attn_k_norm, lam_q1, lam_k1, lam_q2, lam_k2,
              attn_subln, attn_w_out, conv_w_in, conv_w, conv_w_out,
              router_w, moe_w_gate, moe_w_up, moe_w_down):
    cos, sin = axial_rope(x.shape[1], x.dtype)
    xc = ctx
    for l in range(DEPTH):
        ctx_out = any(j % 2 == 0 for j in range(l + 1, DEPTH))
        ctx_in = (l % 2 == 0) or ctx_out
        sh_m, sc_m, g_m, sh_f, sc_f, g_f = ada_params(c, ada_w[l], ada_b[l])
        h = modulate(x, norm_mix[l], sh_m, sc_m)
        hc = None
        cg_m = cg_f = csh_f = csc_f = None
        if ctx_in:
            csh_m, csc_m, cg_m, csh_f, csc_f, cg_f = ada_params(c_ctx, ada_w[l], ada_b[l])
            hc = modulate(xc, norm_mix[l], csh_m, csc_m)
        if l % 2 == 0:
            e = l // 2
            lam_init = 0.8 - 0.6 * math.exp(-0.3 * l)
            lam = (jnp.exp(jnp.sum(lam_q1[e].astype(jnp.float32) * lam_k1[e].astype(jnp.float32)))
                   - jnp.exp(jnp.sum(lam_q2[e].astype(jnp.float32) * lam_k2[e].astype(jnp.float32)))
                   + lam_init)
            y, yc = even_mixer(h, hc, attn_w_in[e], attn_q_norm[e], attn_k_norm[e], lam,
                               attn_subln[e], attn_w_out[e], lam_init, cos, sin, ctx_out)
        else:
            o = l // 2
            y = odd_mixer(h, conv_w_in[o], conv_w[o], conv_w_out[o])
            yc = odd_mixer(hc, conv_w_in[o], conv_w[o], conv_w_out[o]) if ctx_out else None
        x = x + g_m * y
        x = x + g_f * ec_moe(modulate(x, norm_ffn[l], sh_f, sc_f),
                             router_w[l], moe_w_gate[l], moe_w_up[l], moe_w_down[l])
        if ctx_out:
            xc = xc + cg_m * yc
            xc = xc + cg_f * ec_moe(modulate(xc, norm_ffn[l], csh_f, csc_f),
                                    router_w[l], moe_w_gate[l], moe_w_up[l], moe_w_down[l])
    return x
```

```cpp
#include <hip/hip_runtime.h>
#include <hip/hip_cooperative_groups.h>
#include <cstdio>
#include <cstdint>
namespace cg = cooperative_groups;

#ifndef SINGLE_LAUNCH
#define SINGLE_LAUNCH 1
#endif

typedef unsigned short bf16_t;
typedef short bf16x8 __attribute__((ext_vector_type(8)));
typedef float f32x4 __attribute__((ext_vector_type(4)));
typedef unsigned u32x4 __attribute__((ext_vector_type(4)));
typedef unsigned u32x2 __attribute__((ext_vector_type(2)));

#define NTHREADS 512
#define EPSV 1e-6f
#define NPHASES 18
#ifndef DBG_OUTK
#define DBG_OUTK 1024
#endif
#ifndef DBG_REP7
#define DBG_REP7 1
#endif
#ifndef DBG_REP3
#define DBG_REP3 1
#endif
#ifndef DBG_REP0
#define DBG_REP0 1
#endif
#ifndef DBG_REP5
#define DBG_REP5 1
#endif
#ifndef DBG_REPG
#define DBG_REPG 1
#endif
#ifndef DBG_REPS
#define DBG_REPS 1
#endif
#ifndef DBG_REPD
#define DBG_REPD 1
#endif
#ifndef DBG_PHASE_HI
#define DBG_PHASE_HI NPHASES
#endif
#define LDS_BYTES 147456
#define LDS_TOTAL (147456 + 256)

struct Params {
  const float *x, *c, *ctx, *c_ctx, *ada_w, *ada_b, *norm_mix, *norm_ffn, *attn_w_in, *q_norm, *k_norm,
      *lam_q1, *lam_k1, *lam_q2, *lam_k2, *subln, *attn_w_out, *conv_w_in, *conv_w, *conv_w_out,
      *router_w, *moe_gate, *moe_up, *moe_down;
  float* out;
  bf16_t *wt_in0, *wt_out0, *wt_cin, *wt_cout, *wt_gu, *wt_d, *dft, *H, *HC, *Q, *Kb, *Vt, *Zt, *OCAT, *A2, *Zc, *BG;
  float *mods, *rope, *aff, *gate;
  int* idx;
  int* inv;
  bf16_t* Y;
  bf16_t* XB;
  unsigned* counters;
  int phase_lo, phase_hi;
};

typedef __bf16 bf16x2_t __attribute__((ext_vector_type(2)));
typedef float f32x2_t __attribute__((ext_vector_type(2)));
__device__ __forceinline__ unsigned pk_bf16(float lo, float hi) {
  const f32x2_t v = {lo, hi};
  const bf16x2_t r = __builtin_convertvector(v, bf16x2_t);
  return __builtin_bit_cast(unsigned, r);
}
__device__ __forceinline__ float bf2f(unsigned short v) { return __uint_as_float(((unsigned)v) << 16); }
__device__ __forceinline__ float wave_sum(float v) {
#pragma unroll
  for (int o = 32; o > 0; o >>= 1) v += __shfl_xor(v, o);
  return v;
}
__device__ __forceinline__ f32x4 mfma16(bf16x8 a, bf16x8 b, f32x4 c) { return __builtin_amdgcn_mfma_f32_16x16x32_bf16(a, b, c, 0, 0, 0); }

__device__ __forceinline__ int otid() { int t = threadIdx.x; asm volatile("" : "+v"(t)); return t; }

__device__ __forceinline__ int next_unit(unsigned* ctr, int* s_unit) {
  __syncthreads();
  if (threadIdx.x == 0) *s_unit = (int)atomicAdd(ctr, 1u);
  __syncthreads();
  return *s_unit;
}

#define LASP __attribute__((address_space(3)))
__device__ __forceinline__ void glds16(const bf16_t* g, char* l) {
  __builtin_amdgcn_global_load_lds((const unsigned*)g, (LASP unsigned*)l, 16, 0, 0);
}
__device__ __forceinline__ void gemm_mainloop(char* lds, const bf16_t* pa0, const bf16_t* pa1, const bf16_t* pb, size_t ldb, int K, f32x4 (&acc)[4][4]) {
  const int tid = otid(), lane = tid & 63, wave = tid >> 6, wm = wave >> 2, wn = wave & 3, l15 = lane & 15, quad = lane >> 4;
  const int wu = __builtin_amdgcn_readfirstlane(wave);
#pragma unroll
  for (int m = 0; m < 4; ++m)
#pragma unroll
    for (int n = 0; n < 4; ++n) acc[m][n] = (f32x4){0.f, 0.f, 0.f, 0.f};
  const int nk = K >> 6;
  const bf16_t* pb1 = pb + 64 * ldb;
  const bf16_t* pb2 = pb + 128 * ldb;
  const bf16_t* pb3 = pb + 192 * ldb;
  char* lw = lds + wu * 1024;
#define GEMM_ISSUE(o, dst) do { glds16(pa0 + (o), (dst)); glds16(pa1 + (o), (dst) + 8192); glds16(pb + (o), (dst) + 16384); glds16(pb1 + (o), (dst) + 16384 + 8192); \
    glds16(pb2 + (o), (dst) + 16384 + 16384); glds16(pb3 + (o), (dst) + 16384 + 24576); } while (0)
  GEMM_ISSUE(0, lw);
  GEMM_ISSUE(64, lw + 49152);
  asm volatile("s_waitcnt vmcnt(6)" ::: "memory");
  __builtin_amdgcn_s_barrier();
  asm volatile("" ::: "memory");
  int aoff[2], boff[2];
#pragma unroll
  for (int ks = 0; ks < 2; ++ks) {
    const int sw = (((ks * 4 + quad) ^ ((l15 >> 1) & 7)) * 16);
    aoff[ks] = (wm * 64 + l15) * 128 + sw;
    boff[ks] = 16384 + (wn * 64 + l15) * 128 + sw;
  }
  bf16x8 af0[4], bf0[4], af1[4], bf1[4];
#pragma unroll
  for (int m = 0; m < 4; ++m) af0[m] = *(const bf16x8*)(lds + aoff[0] + m * 2048);
#pragma unroll
  for (int n = 0; n < 4; ++n) bf0[n] = *(const bf16x8*)(lds + boff[0] + n * 2048);
  int scur = 0;
  for (int kt = 0; kt < nk; ++kt) {
    const char* st = lds + scur * 49152;
    const bool has1 = (kt + 1 < nk), has2 = (kt + 2 < nk);
    int s1 = scur + 1; if (s1 >= 3) s1 -= 3;
    if (has2) {
      int s2 = scur + 2; if (s2 >= 3) s2 -= 3;
      char* nx = lw + s2 * 49152;
      const int o = (kt + 2) * 64;
      GEMM_ISSUE(o, nx);
    }
#pragma unroll
    for (int m = 0; m < 4; ++m) af1[m] = *(const bf16x8*)(st + aoff[1] + m * 2048);
#pragma unroll
    for (int n = 0; n < 4; ++n) bf1[n] = *(const bf16x8*)(st + boff[1] + n * 2048);
    __builtin_amdgcn_sched_barrier(0);
#pragma unroll
    for (int m = 0; m < 4; ++m)
#pragma unroll
      for (int n = 0; n < 4; ++n) acc[m][n] = mfma16(bf0[n], af0[m], acc[m][n]);
    __builtin_amdgcn_sched_barrier(0);
    if (has2) asm volatile("s_waitcnt vmcnt(6) lgkmcnt(0)" ::: "memory"); else asm volatile("s_waitcnt vmcnt(0) lgkmcnt(0)" ::: "memory");
    __builtin_amdgcn_s_barrier();
    asm volatile("" ::: "memory");
    if (has1) {
      const char* sn = lds + s1 * 49152;
#pragma unroll
      for (int m = 0; m < 4; ++m) af0[m] = *(const bf16x8*)(sn + aoff[0] + m * 2048);
#pragma unroll
      for (int n = 0; n < 4; ++n) bf0[n] = *(const bf16x8*)(sn + boff[0] + n * 2048);
    }
    __builtin_amdgcn_sched_barrier(0);
#pragma unroll
    for (int m = 0; m < 4; ++m)
#pragma unroll
      for (int n = 0; n < 4; ++n) acc[m][n] = mfma16(bf1[n], af1[m], acc[m][n]);
    __builtin_amdgcn_sched_barrier(0);
    scur = s1;
  }
  asm volatile("s_waitcnt lgkmcnt(0)" ::: "memory");
  __builtin_amdgcn_s_barrier();
  asm volatile("" ::: "memory");
#undef GEMM_ISSUE
}

__device__ __forceinline__ f32x4 load4_bf16(const bf16_t* p) {
  const u32x2 w = *(const u32x2*)p;
  return (f32x4){__uint_as_float(w.x << 16), __uint_as_float(w.x & 0xffff0000u), __uint_as_float(w.y << 16), __uint_as_float(w.y & 0xffff0000u)};
}
__device__ __forceinline__ void store4_bf16(bf16_t* p, f32x4 v) {
  u32x2 w;
  w.x = pk_bf16(v[0], v[1]);
  w.y = pk_bf16(v[2], v[3]);
  *(u32x2*)p = w;
}

#define P0_GEMV 384
#define P0_DFT 256
#define P0_FOLD 128
#define P0_ROPE 1
#define P0_CVT CVT_SMALL
#define P0_TOTAL (P0_GEMV + P0_DFT + P0_FOLD + P0_ROPE + P0_CVT)

__device__ void p0_gemv(const Params& P, char* lds, int u) {
  const int tid = otid();
  const int l = u / 192, cb = u % 192, col0 = cb * 32;
  float* sc = (float*)lds;
  float* red = (float*)(lds + 20480);
  for (int i = tid; i < 5 * 1024; i += NTHREADS) {
    const int r = i >> 10, k = i & 1023;
    const float v = (r < 4) ? P.c[r * 1024 + k] : P.c_ctx[k];
    sc[i] = v / (1.f + __expf(-v));
  }
  __syncthreads();
  const int col = tid & 31, kp = tid >> 5;
  float a0 = 0.f, a1 = 0.f, a2 = 0.f, a3 = 0.f, a4 = 0.f;
  const float* w = P.ada_w + ((size_t)l * 1024 + kp * 64) * 6144 + col0 + col;
#pragma unroll 16
  for (int k = 0; k < 64; ++k) {
    const float wv = w[(size_t)k * 6144];
    const int kk = kp * 64 + k;
    a0 += sc[kk] * wv; a1 += sc[1024 + kk] * wv; a2 += sc[2048 + kk] * wv; a3 += sc[3072 + kk] * wv; a4 += sc[4096 + kk] * wv;
  }
  red[(kp * 5 + 0) * 32 + col] = a0; red[(kp * 5 + 1) * 32 + col] = a1; red[(kp * 5 + 2) * 32 + col] = a2;
  red[(kp * 5 + 3) * 32 + col] = a3; red[(kp * 5 + 4) * 32 + col] = a4;
  __syncthreads();
  if (tid < 160) {
    const int r = tid >> 5, cc = tid & 31;
    float sum = 0.f;
#pragma unroll
    for (int q = 0; q < 16; ++q) sum += red[(q * 5 + r) * 32 + cc];
    P.mods[((size_t)l * 5 + r) * 6144 + col0 + cc] = sum + P.ada_b[l * 6144 + col0 + cc];
  }
}

__device__ void p0_dft(const Params& P, char* lds, int u) {
  const int tid = otid();
  float* tab = (float*)lds;
  for (int i = tid; i < 4096; i += NTHREADS) tab[i] = cospif((float)i * (1.f / 2048.f));
  __syncthreads();
  for (int kr = 0; kr < 8; ++kr) {
    const int k = u * 8 + kr;
    unsigned cw[4], sw[4];
#pragma unroll
    for (int i = 0; i < 4; ++i) {
      const int n0 = tid * 8 + 2 * i;
      const int p0 = (k * n0) & 4095, p1 = (k * (n0 + 1)) & 4095;
      cw[i] = pk_bf16(tab[p0], tab[p1]);
      sw[i] = pk_bf16(tab[(p0 + 1024) & 4095], tab[(p1 + 1024) & 4095]);
    }
    *(u32x4*)(P.dft + (size_t)k * 8192 + tid * 8) = (u32x4){cw[0], cw[1], cw[2], cw[3]};
    *(u32x4*)(P.dft + (size_t)k * 8192 + 4096 + tid * 8) = (u32x4){sw[0], sw[1], sw[2], sw[3]};
  }
}

__device__ void p0_fold(const Params& P, char* lds, int u) {
  const int tid = otid();
  float* tab = (float*)lds;
  float* wl = (float*)(lds + 256);
  const int k0 = u * 8;
  if (tid < 64) tab[tid] = cospif((float)tid * (1.f / 32.f));
  {
    const int r = tid >> 6, c4 = (tid & 63) * 4;
    *(f32x4*)(wl + r * 256 + c4) = *(const f32x4*)(P.attn_w_in + (size_t)(k0 + r) * 2560 + 2304 + c4);
  }
  __syncthreads();
  const int col = tid & 255, kh = tid >> 8, g = col >> 6, cp = col & 63;
  float sa[4] = {0.f, 0.f, 0.f, 0.f}, sb[4] = {0.f, 0.f, 0.f, 0.f};
#pragma unroll 4
  for (int c = 0; c < 64; ++c) {
    const int ph = (c * cp) & 63;
    const float tc = tab[ph], ts = tab[(ph + 48) & 63];
#pragma unroll
    for (int j = 0; j < 4; ++j) { const float w = wl[(kh * 4 + j) * 256 + g * 64 + c]; sa[j] += w * tc; sb[j] += w * ts; }
  }
  u32x2 wa, wb;
  wa.x = pk_bf16(sa[0], sa[1]); wa.y = pk_bf16(sa[2], sa[3]); wb.x = pk_bf16(sb[0], sb[1]); wb.y = pk_bf16(sb[2], sb[3]);
  *(u32x2*)(P.wt_in0 + (size_t)(2304 + col) * 1024 + k0 + kh * 4) = wa;
  *(u32x2*)(P.wt_in0 + (size_t)(2560 + col) * 1024 + k0 + kh * 4) = wb;
}

__device__ void p0_rope(const Params& P) {
  for (int i = threadIdx.x; i < 1024; i += NTHREADS) {
    const int pos = i >> 4, j = i & 15;
    const float inv = powf(10000.f, -(float)j / 16.f);
    const float ang = (float)pos * inv;
    P.rope[i] = cosf(ang);
    P.rope[1024 + i] = sinf(ang);
  }
}

#define CVT_SMALL 464
#define CVT_GU_PER 128
#define CVT_D_PER 64
#define CVT_MOE_PER_LAYER (16 * (CVT_GU_PER + CVT_D_PER))
__device__ __forceinline__ void cvt_decode(const Params& P, int t, int tid, const float*& sp, int& ld, bf16_t*& dp) {
  const float *p0, *p1;
  bf16_t* dst;
  int type;
  if (t < 144) { p0 = P.attn_w_in; p1 = p0; dst = P.wt_in0; ld = 2560; type = 0; }
  else if (t < 208) { t -= 144; p0 = P.attn_w_out; p1 = p0; dst = P.wt_out0; ld = 1024; type = 0; }
  else if (t < 336) { t -= 208; p0 = P.conv_w_in + 1024; p1 = P.conv_w_in + 2048; dst = P.wt_cin; ld = 3072; type = 1; }
  else if (t < 400) { t -= 336; p0 = P.conv_w_in; p1 = p0; dst = P.wt_cin + (size_t)2048 * 1024; ld = 3072; type = 0; }
  else if (t < 464) { t -= 400; p0 = P.conv_w_out; p1 = p0; dst = P.wt_cout; ld = 1024; type = 0; }
  else {
    t -= 464;
    const int layer = t / CVT_MOE_PER_LAYER; t -= layer * CVT_MOE_PER_LAYER;
    if (t < 16 * CVT_GU_PER) { const int mat = layer * 16 + t / CVT_GU_PER; t %= CVT_GU_PER; p0 = P.moe_gate + (size_t)mat * 1048576; p1 = P.moe_up + (size_t)mat * 1048576;
      dst = P.wt_gu + (size_t)mat * 2048 * 1024; ld = 1024; type = 1; }
    else { t -= 16 * CVT_GU_PER; const int mat = layer * 16 + t / CVT_D_PER; t %= CVT_D_PER; p0 = P.moe_down + (size_t)mat * 1048576; p1 = p0; dst = P.wt_d + (size_t)mat * 1048576; ld = 1024; type = 0; }
  }
  const int rb = t >> 2, kq = t & 3;
  {
    const int k = tid >> 3, ch = tid & 7;
    const int r = rb * 64 + ch * 8;
    const float* src;
    int col;
    if (type == 0) { src = p0; col = r; }
    else { const int j = r >> 8, q = (r & 255) >> 4, w = r & 15; col = j * 128 + (q >> 1) * 16 + w; src = (q & 1) ? p1 : p0; }
    sp = src + (size_t)(kq * 256 + k) * ld + col;
  }
  {
    const int n = tid >> 3, kc = tid & 7;
    dp = dst + (size_t)(rb * 64 + n) * 1024 + kq * 256 + kc * 8;
  }
}
__device__ __forceinline__ void cvt_load(const float* sp, int ld, f32x4 (&v)[4][2]) {
#pragma unroll
  for (int sb = 0; sb < 4; ++sb) { v[sb][0] = *(const f32x4*)(sp + (size_t)sb * 64 * ld); v[sb][1] = *(const f32x4*)(sp + (size_t)sb * 64 * ld + 4); }
}
__device__ __forceinline__ void cvt_finish(char* lds, int tid, bf16_t* dp, const f32x4 (&v)[4][2]) {
  float* tile = (float*)lds;
  {
    const int k = tid >> 3, ch = tid & 7;
#pragma unroll
    for (int sb = 0; sb < 4; ++sb) {
      float* tp = tile + sb * 4160 + k * 65 + ch * 8;
      tp[0] = v[sb][0][0]; tp[1] = v[sb][0][1]; tp[2] = v[sb][0][2]; tp[3] = v[sb][0][3]; tp[4] = v[sb][1][0]; tp[5] = v[sb][1][1]; tp[6] = v[sb][1][2]; tp[7] = v[sb][1][3];
    }
  }
  __syncthreads();
  {
    const int n = tid >> 3, kc = tid & 7;
#pragma unroll
    for (int sb = 0; sb < 4; ++sb) {
      const float* tp = tile + sb * 4160 + (kc * 8) * 65 + n;
      u32x4 w;
      w.x = pk_bf16(tp[0], tp[65]); w.y = pk_bf16(tp[130], tp[195]); w.z = pk_bf16(tp[260], tp[325]); w.w = pk_bf16(tp[390], tp[455]);
      *(u32x4*)(dp + sb * 64) = w;
    }
  }
}
__device__ __forceinline__ void cvt_stream(const Params& P, char* lds, int tfirst, int tstride, int tend) {
  const int tid = otid();
  if (tfirst >= tend) return;
  const float* sp; int ld; bf16_t* dp;
  f32x4 va[4][2], vb[4][2];
  cvt_decode(P, tfirst, tid, sp, ld, dp);
  cvt_load(sp, ld, va);
  for (int t = tfirst; t < tend; t += tstride) {
    const int tn = t + tstride;
    const bool more = tn < tend;
    bf16_t* dpn = dp;
    if (more) { const float* spn; int ldn; cvt_decode(P, tn, tid, spn, ldn, dpn); cvt_load(spn, ldn, vb); }
    __syncthreads();
    cvt_finish(lds, tid, dp, va);
    if (more) {
#pragma unroll
      for (int sb = 0; sb < 4; ++sb) { va[sb][0] = vb[sb][0]; va[sb][1] = vb[sb][1]; }
      dp = dpn;
    }
  }
}

__device__ __forceinline__ void cvt_one(const Params& P, char* lds, int t) {
  const int tid = otid();
  const float* sp; int ld; bf16_t* dp;
  f32x4 v[4][2];
  cvt_decode(P, t, tid, sp, ld, dp);
  cvt_load(sp, ld, v);
  cvt_finish(lds, tid, dp, v);
}

__device__ __forceinline__ void moe_combine_rows2(const Params& P, int l, int row0, int lane, f32x4 (&v)[2][4]) {
  const int b = row0 >> 12;
  int myslot[2];
#pragma unroll
  for (int rr = 0; rr < 2; ++rr) myslot[rr] = P.inv[(size_t)(row0 + rr) * 16 + (lane & 15)];
  f32x4 a[2][4];
  unsigned mask[2];
#pragma unroll
  for (int rr = 0; rr < 2; ++rr) {
#pragma unroll
    for (int j = 0; j < 4; ++j) a[rr][j] = (f32x4){0.f, 0.f, 0.f, 0.f};
    mask[rr] = (unsigned)(__ballot(myslot[rr] >= 0) & 0xffffull);
  }
  while (mask[0] | mask[1]) {
    int ee[2][2], sl[2][2]; float vl[2][2];
#pragma unroll
    for (int rr = 0; rr < 2; ++rr)
#pragma unroll
      for (int k = 0; k < 2; ++k) {
        if (mask[rr]) { ee[rr][k] = __builtin_ctz(mask[rr]); mask[rr] &= mask[rr] - 1u; sl[rr][k] = __builtin_amdgcn_readlane(myslot[rr], ee[rr][k]); vl[rr][k] = 1.f; }
        else { ee[rr][k] = 0; sl[rr][k] = 0; vl[rr][k] = 0.f; }
      }
    float gt[2][2]; u32x2 w[2][2][4];
#pragma unroll
    for (int rr = 0; rr < 2; ++rr)
#pragma unroll
      for (int k = 0; k < 2; ++k) {
        const int be = b * 16 + ee[rr][k];
        gt[rr][k] = P.gate[be * 512 + sl[rr][k]] * vl[rr][k];
        const bf16_t* yp = P.Y + ((size_t)be * 512 + sl[rr][k]) * 1024 + lane * 4;
#pragma unroll
        for (int j = 0; j < 4; ++j) w[rr][k][j] = *(const u32x2*)(yp + j * 256);
      }
#pragma unroll
    for (int rr = 0; rr < 2; ++rr)
#pragma unroll
      for (int k = 0; k < 2; ++k)
#pragma unroll
        for (int j = 0; j < 4; ++j) {
          a[rr][j][0] += gt[rr][k] * __uint_as_float(w[rr][k][j].x << 16); a[rr][j][1] += gt[rr][k] * __uint_as_float(w[rr][k][j].x & 0xffff0000u);
          a[rr][j][2] += gt[rr][k] * __uint_as_float(w[rr][k][j].y << 16); a[rr][j][3] += gt[rr][k] * __uint_as_float(w[rr][k][j].y & 0xffff0000u);
        }
  }
  const float* gf = P.mods + ((size_t)l * 5 + b) * 6144 + 5120;
#pragma unroll
  for (int j = 0; j < 4; ++j) {
    const f32x4 g = *(const f32x4*)(gf + j * 256 + lane * 4);
    v[0][j] += g * a[0][j]; v[1][j] += g * a[1][j];
  }
}

__device__ void phase_combine(const Params& P, int l) {
  const int tid_ = otid(); const int lane = tid_ & 63, wave = tid_ >> 6;
  for (int row0 = (blockIdx.x * 8 + wave) * 2; row0 < 16384; row0 += gridDim.x * 16) {
    const bf16_t* src = P.XB + (size_t)row0 * 1024;
    float* dstf = P.out + (size_t)row0 * 1024;
    f32x4 v[2][4];
#pragma unroll
    for (int rr = 0; rr < 2; ++rr)
#pragma unroll
      for (int j = 0; j < 4; ++j) v[rr][j] = load4_bf16(src + rr * 1024 + j * 256 + lane * 4);
    moe_combine_rows2(P, l, row0, lane, v);
#pragma unroll
    for (int rr = 0; rr < 2; ++rr)
#pragma unroll
      for (int j = 0; j < 4; ++j) *(f32x4*)(dstf + rr * 1024 + j * 256 + lane * 4) = v[rr][j];
  }
}

__device__ void phase_modulate(const Params& P, const float* xin, int l, bool with_ctx, int comb_l) {
  const int tid_ = otid(); const int lane = tid_ & 63, wave = tid_ >> 6;
  const int nrows = with_ctx ? 17408 : 16384;
  for (int row0 = (blockIdx.x * 8 + wave) * 2; row0 < nrows; row0 += gridDim.x * 16) {
    const float* src; bf16_t* dst; int mr;
    if (row0 < 16384) { src = xin + (size_t)row0 * 1024; dst = P.H + (size_t)row0 * 1024; mr = row0 >> 12; }
    else { src = P.ctx + (size_t)(row0 - 16384) * 1024; dst = P.HC + (size_t)(row0 - 16384) * 1024; mr = 4; }
    f32x4 v[2][4];
    if (comb_l >= 0) {
#pragma unroll
      for (int rr = 0; rr < 2; ++rr)
#pragma unroll
        for (int j = 0; j < 4; ++j) v[rr][j] = load4_bf16(P.XB + (size_t)(row0 + rr) * 1024 + j * 256 + lane * 4);
      moe_combine_rows2(P, comb_l, row0, lane, v);
#pragma unroll
      for (int rr = 0; rr < 2; ++rr)
#pragma unroll
        for (int j = 0; j < 4; ++j) {
          store4_bf16(P.XB + (size_t)(row0 + rr) * 1024 + j * 256 + lane * 4, v[rr][j]);
        }
    } else {
#pragma unroll
      for (int rr = 0; rr < 2; ++rr)
#pragma unroll
        for (int j = 0; j < 4; ++j) v[rr][j] = *(const f32x4*)(src + rr * 1024 + j * 256 + lane * 4);
    }
    float rinv[2];
#pragma unroll
    for (int rr = 0; rr < 2; ++rr) {
      float ss = 0.f;
#pragma unroll
      for (int j = 0; j < 4; ++j) ss += v[rr][j][0] * v[rr][j][0] + v[rr][j][1] * v[rr][j][1] + v[rr][j][2] * v[rr][j][2] + v[rr][j][3] * v[rr][j][3];
      ss = wave_sum(ss);
      rinv[rr] = rsqrtf(ss * (1.f / 1024.f) + EPSV);
    }
    const float* md = P.mods + ((size_t)l * 5 + mr) * 6144;
#pragma unroll
    for (int j = 0; j < 4; ++j) {
      const int col = j * 256 + lane * 4;
      const f32x4 g = *(const f32x4*)(P.norm_mix + l * 1024 + col), sh = *(const f32x4*)(md + col), sc = *(const f32x4*)(md + 1024 + col);
#pragma unroll
      for (int rr = 0; rr < 2; ++rr) {
        f32x4 y;
#pragma unroll
        for (int i = 0; i < 4; ++i) y[i] = (v[rr][j][i] * rinv[rr] * g[i]) * (1.f + sc[i]) + sh[i];
        store4_bf16(dst + rr * 1024 + col, y);
      }
    }
  }
}

__device__ void phase_router(const Params& P, char* lds, int l) {
  const int tid = otid(); const int lane = tid & 63, wave = tid >> 6;
  float* wl = (float*)lds;
  __syncthreads();
  for (int i = tid; i < 4096; i += NTHREADS) {
    const int d = i >> 2, q = i & 3;
    const f32x4 w = *(const f32x4*)(P.router_w + ((size_t)l * 1024 + d) * 16 + q * 4);
    wl[(q * 4 + 0) * 1024 + d] = w[0]; wl[(q * 4 + 1) * 1024 + d] = w[1]; wl[(q * 4 + 2) * 1024 + d] = w[2]; wl[(q * 4 + 3) * 1024 + d] = w[3];
  }
  __syncthreads();
  for (int row0 = (blockIdx.x * 8 + wave) * 2; row0 < 16384; row0 += gridDim.x * 16) {
    const int b = row0 >> 12;
    f32x4 v[2][4];
    float rinv[2];
#pragma unroll
    for (int rr = 0; rr < 2; ++rr) {
      const bf16_t* src = P.XB + (size_t)(row0 + rr) * 1024;
#pragma unroll
      for (int j = 0; j < 4; ++j) v[rr][j] = load4_bf16(src + j * 256 + lane * 4);
    }
#pragma unroll
    for (int rr = 0; rr < 2; ++rr) {
      float ss = 0.f;
#pragma unroll
      for (int j = 0; j < 4; ++j) ss += v[rr][j][0] * v[rr][j][0] + v[rr][j][1] * v[rr][j][1] + v[rr][j][2] * v[rr][j][2] + v[rr][j][3] * v[rr][j][3];
      ss = wave_sum(ss);
      rinv[rr] = rsqrtf(ss * (1.f / 1024.f) + EPSV);
    }
    const float* md = P.mods + ((size_t)l * 5 + b) * 6144;
#pragma unroll
    for (int j = 0; j < 4; ++j) {
      const int col = j * 256 + lane * 4;
      const f32x4 g = *(const f32x4*)(P.norm_ffn + l * 1024 + col), sh = *(const f32x4*)(md + 3072 + col), sc = *(const f32x4*)(md + 4096 + col);
#pragma unroll
      for (int rr = 0; rr < 2; ++rr) {
#pragma unroll
        for (int i = 0; i < 4; ++i) v[rr][j][i] = (v[rr][j][i] * rinv[rr] * g[i]) * (1.f + sc[i]) + sh[i];
        store4_bf16(P.H + (size_t)(row0 + rr) * 1024 + col, v[rr][j]);
      }
    }
    float v32[32];
#pragma unroll
    for (int e = 0; e < 16; ++e) {
      float a0 = 0.f, a1 = 0.f;
#pragma unroll
      for (int j = 0; j < 4; ++j) {
        const f32x4 w = *(const f32x4*)(wl + e * 1024 + j * 256 + lane * 4);
        a0 += v[0][j][0] * w[0] + v[0][j][1] * w[1] + v[0][j][2] * w[2] + v[0][j][3] * w[3];
        a1 += v[1][j][0] * w[0] + v[1][j][1] * w[1] + v[1][j][2] * w[2] + v[1][j][3] * w[3];
      }
      v32[e] = a0; v32[16 + e] = a1;
      if (e & 1) __builtin_amdgcn_sched_barrier(0);
    }
    const bool b5 = (lane & 32) != 0, b4 = (lane & 16) != 0, b3 = (lane & 8) != 0, b2 = (lane & 4) != 0, b1 = (lane & 2) != 0;
    float w16[16];
#pragma unroll
    for (int i = 0; i < 16; ++i) { const float keep = b5 ? v32[i + 16] : v32[i], send = b5 ? v32[i] : v32[i + 16]; w16[i] = keep + __shfl_xor(send, 32); }
    float w8[8];
#pragma unroll
    for (int i = 0; i < 8; ++i) { const float keep = b4 ? w16[i + 8] : w16[i], send = b4 ? w16[i] : w16[i + 8]; w8[i] = keep + __shfl_xor(send, 16); }
    float w4[4];
#pragma unroll
    for (int i = 0; i < 4; ++i) { const float keep = b3 ? w8[i + 4] : w8[i], send = b3 ? w8[i] : w8[i + 4]; w4[i] = keep + __shfl_xor(send, 8); }
    float w2[2];
#pragma unroll
    for (int i = 0; i < 2; ++i) { const float keep = b2 ? w4[i + 2] : w4[i], send = b2 ? w4[i] : w4[i + 2]; w2[i] = keep + __shfl_xor(send, 4); }
    float z = (b1 ? w2[1] : w2[0]) + __shfl_xor(b1 ? w2[0] : w2[1], 2);
    z += __shfl_xor(z, 1);
    float mx = z;
    mx = fmaxf(mx, __shfl_xor(mx, 2)); mx = fmaxf(mx, __shfl_xor(mx, 4)); mx = fmaxf(mx, __shfl_xor(mx, 8)); mx = fmaxf(mx, __shfl_xor(mx, 16));
    const float ex = __expf(z - mx);
    float sum = ex;
    sum += __shfl_xor(sum, 2); sum += __shfl_xor(sum, 4); sum += __shfl_xor(sum, 8); sum += __shfl_xor(sum, 16);
    if ((lane & 1) == 0) {
      const int rr = lane >> 5, e = (lane >> 1) & 15, n = (row0 + rr) & 4095;
      P.aff[((size_t)b * 16 + e) * 4096 + n] = ex / sum;
    }
  }
}

__device__ void topk_unit(const Params& P, char* lds, int be) {
  const int tid = otid(), lane = tid & 63, wave = tid >> 6;
  unsigned* keys = (unsigned*)lds;
  unsigned* wsum = (unsigned*)(lds + 16384);
  const float* a = P.aff + (size_t)be * 4096;
  unsigned kv[8];
#pragma unroll
  for (int i = 0; i < 8; ++i) { kv[i] = __float_as_uint(a[tid * 8 + i]); keys[tid * 8 + i] = kv[i]; }
  unsigned prefix = 0;
  for (int bit = 31; bit >= 0; --bit) {
    const unsigned cand = prefix | (1u << bit);
    unsigned cnt = 0;
#pragma unroll
    for (int i = 0; i < 8; ++i) cnt += (kv[i] >= cand) ? 1u : 0u;
#pragma unroll
    for (int o = 32; o > 0; o >>= 1) cnt += __shfl_xor(cnt, o);
    __syncthreads();
    if (lane == 0) wsum[wave] = cnt;
    __syncthreads();
    unsigned tot = 0;
#pragma unroll
    for (int w = 0; w < 8; ++w) tot += wsum[w];
    if (tot >= 512u) prefix = cand;
  }
  unsigned gt = 0, eq = 0;
#pragma unroll
  for (int i = 0; i < 8; ++i) { gt += (kv[i] > prefix) ? 1u : 0u; eq += (kv[i] == prefix) ? 1u : 0u; }
  unsigned packed = gt | (eq << 16);
  unsigned incl = packed;
#pragma unroll
  for (int o = 1; o < 64; o <<= 1) { const unsigned t = __shfl_up(incl, o); if (lane >= o) incl += t; }
  __syncthreads();
  if (lane == 63) wsum[wave] = incl;
  __syncthreads();
  unsigned base = 0, total = 0;
#pragma unroll
  for (int w = 0; w < 8; ++w) { const unsigned s = wsum[w]; if (w < wave) base += s; total += s; }
  const unsigned excl = base + incl - packed;
  unsigned gpos = excl & 0xffffu, epos = excl >> 16;
  const unsigned ngt = total & 0xffffu;
  const unsigned need = 512u - ngt;
#pragma unroll
  for (int i = 0; i < 8; ++i) {
    const int n = tid * 8 + i;
    int slot = -1;
    if (kv[i] > prefix) { slot = (int)gpos; ++gpos; }
    else if (kv[i] == prefix) { if (epos < need) slot = (int)(ngt + epos); ++epos; }
    if (slot >= 0) { P.idx[be * 512 + slot] = n; P.gate[be * 512 + slot] = __uint_as_float(kv[i]); }
    P.inv[((size_t)(be >> 4) * 4096 + n) * 16 + (be & 15)] = slot;
  }
}

__device__ void phase_conv(const Params& P) {
  const size_t nitems = (size_t)16384 * 128;
  for (size_t it = (size_t)blockIdx.x * NTHREADS + threadIdx.x; it < nitems; it += (size_t)gridDim.x * NTHREADS) {
    const int t = (int)(it >> 7), c0 = (int)(it & 127) * 8, n = t & 4095;
    const u32x4 zc = *(const u32x4*)(P.Zc + (size_t)t * 1024 + c0);
    u32x4 zp = (u32x4){0, 0, 0, 0}, zn = (u32x4){0, 0, 0, 0};
    if (n > 0) zp = *(const u32x4*)(P.Zc + (size_t)(t - 1) * 1024 + c0);
    if (n < 4095) zn = *(const u32x4*)(P.Zc + (size_t)(t + 1) * 1024 + c0);
    const u32x4 bg = *(const u32x4*)(P.BG + (size_t)t * 1024 + c0);
    u32x4 o;
#pragma unroll
    for (int i = 0; i < 4; ++i) {
      const int c = c0 + 2 * i;
      const float w00 = P.conv_w[c], w01 = P.conv_w[1024 + c], w02 = P.conv_w[2048 + c];
      const float w10 = P.conv_w[c + 1], w11 = P.conv_w[1024 + c + 1], w12 = P.conv_w[2048 + c + 1];
      const float lo = bf2f((unsigned short)(bg[i] & 0xffff)) * (w00 * bf2f((unsigned short)(zp[i] & 0xffff)) + w01 * bf2f((unsigned short)(zc[i] & 0xffff)) + w02 * bf2f((unsigned short)(zn[i] & 0xffff)));
      const float hi = bf2f((unsigned short)(bg[i] >> 16)) * (w10 * bf2f((unsigned short)(zp[i] >> 16)) + w11 * bf2f((unsigned short)(zc[i] >> 16)) + w12 * bf2f((unsigned short)(zn[i] >> 16)));
      o[i] = pk_bf16(lo, hi);
    }
    *(u32x4*)(P.OCAT + (size_t)t * 1024 + c0) = o;
  }
}

#define GEMM_PRE() const int tid = otid(), lane = tid & 63, wave = tid >> 6, wm = wave >> 2, wn = wave & 3, l15 = lane & 15, quad = lane >> 4, lr = tid >> 3, lc = ((tid & 7) ^ ((tid >> 4) & 7)) * 8;     \
  f32x4 acc[4][4]; (void)lane; (void)wm; (void)wn; (void)l15; (void)quad;

__device__ void inproj_unit(const Params& P, char* lds, int u) {
  GEMM_PRE();
  if (u < 768) {
    const int mt = u / 6, nt = u % 6;
    gemm_mainloop(lds, P.H + (size_t)(mt * 128 + lr) * 1024 + lc, P.H + (size_t)(mt * 128 + 64 + lr) * 1024 + lc, P.wt_in0 + (size_t)(nt * 256 + lr) * 1024 + lc, 1024, 1024, acc);
    const int nb = nt * 256 + wn * 64;
    const bool isq = nb < 768;
    const float* gn = isq ? P.q_norm : P.k_norm;
    f32x4 gv[4];
#pragma unroll
    for (int n = 0; n < 4; ++n) gv[n] = *(const f32x4*)(gn + n * 16 + quad * 4);
#pragma unroll
    for (int m = 0; m < 4; ++m) {
      const int t = mt * 128 + wm * 64 + m * 16 + l15, b = t >> 12, np = t & 4095, pr = np >> 6, pc = np & 63;
      float ss = 0.f;
#pragma unroll
      for (int n = 0; n < 4; ++n) ss += acc[m][n][0] * acc[m][n][0] + acc[m][n][1] * acc[m][n][1] + acc[m][n][2] * acc[m][n][2] + acc[m][n][3] * acc[m][n][3];
      ss += __shfl_xor(ss, 16); ss += __shfl_xor(ss, 32);
      const float rinv = rsqrtf(ss * (1.f / 64.f) + EPSV);
      const f32x4 cr = *(const f32x4*)(P.rope + pr * 16 + quad * 4), sr = *(const f32x4*)(P.rope + 1024 + pr * 16 + quad * 4);
      const f32x4 cc = *(const f32x4*)(P.rope + pc * 16 + quad * 4), sc = *(const f32x4*)(P.rope + 1024 + pc * 16 + quad * 4);
      f32x4 x0 = acc[m][0] * rinv * gv[0], x1 = acc[m][1] * rinv * gv[1], x2 = acc[m][2] * rinv * gv[2], x3 = acc[m][3] * rinv * gv[3];
      f32x4 y0 = x0 * cr - x1 * sr, y1 = x1 * cr + x0 * sr, y2 = x2 * cc - x3 * sc, y3 = x3 * cc + x2 * sc;
      bf16_t* dp;
      if (isq) { const float qs = 0.125f * 1.44269504f; y0 *= qs; y1 *= qs; y2 *= qs; y3 *= qs; dp = P.Q + (size_t)t * 768 + nb + quad * 4; }
      else dp = P.Kb + ((size_t)b * 4352 + np) * 768 + (nb - 768) + quad * 4;
      store4_bf16(dp, y0); store4_bf16(dp + 16, y1); store4_bf16(dp + 32, y2); store4_bf16(dp + 48, y3);
    }
  } else if (u < 1152) {
    const int id = u - 768, mt = id >> 6, nt = id & 63;
    gemm_mainloop(lds, P.wt_in0 + (size_t)(1536 + mt * 128 + lr) * 1024 + lc, P.wt_in0 + (size_t)(1536 + mt * 128 + 64 + lr) * 1024 + lc, P.H + (size_t)(nt * 256 + lr) * 1024 + lc, 1024, 1024, acc);
#pragma unroll
    for (int m = 0; m < 4; ++m) {
      const int c = mt * 128 + wm * 64 + m * 16 + l15;
#pragma unroll
      for (int n = 0; n < 4; ++n) {
        const int t = nt * 256 + wn * 64 + n * 16 + quad * 4, b = t >> 12, np = t & 4095;
        store4_bf16(P.Vt + ((size_t)b * 768 + c) * 4352 + (np & ~31) + quad * 8 + (n & 1) * 4, acc[m][n]);
      }
    }
  } else if (u < 1408) {
    const int id = u - 1152, mt = id >> 6, nt = id & 63;
    gemm_mainloop(lds, P.wt_in0 + (size_t)(2304 + mt * 128 + lr) * 1024 + lc, P.wt_in0 + (size_t)(2304 + mt * 128 + 64 + lr) * 1024 + lc, P.H + (size_t)(nt * 256 + lr) * 1024 + lc, 1024, 1024, acc);
#pragma unroll
    for (int m = 0; m < 4; ++m) {
      const int jj = mt * 128 + wm * 64 + m * 16 + l15, which = jj >> 8, cp = jj & 255;
#pragma unroll
      for (int n = 0; n < 4; ++n) {
        const int t = nt * 256 + wn * 64 + n * 16 + quad * 4, b = t >> 12, np = t & 4095;
        store4_bf16(P.Zt + ((size_t)b * 256 + cp) * 8192 + which * 4096 + np, acc[m][n]);
      }
    }
  } else if (u < 1432) {
    const int id = u - 1408, mt = id / 3, nt = id % 3;
    gemm_mainloop(lds, P.HC + (size_t)(mt * 128 + lr) * 1024 + lc, P.HC + (size_t)(mt * 128 + 64 + lr) * 1024 + lc, P.wt_in0 + (size_t)(768 + nt * 256 + lr) * 1024 + lc, 1024, 1024, acc);
    const int nb = nt * 256 + wn * 64;
    f32x4 gv[4];
#pragma unroll
    for (int n = 0; n < 4; ++n) gv[n] = *(const f32x4*)(P.k_norm + n * 16 + quad * 4);
#pragma unroll
    for (int m = 0; m < 4; ++m) {
      const int rr = mt * 128 + wm * 64 + m * 16 + l15, b = rr >> 8, j = rr & 255;
      float ss = 0.f;
#pragma unroll
      for (int n = 0; n < 4; ++n) ss += acc[m][n][0] * acc[m][n][0] + acc[m][n][1] * acc[m][n][1] + acc[m][n][2] * acc[m][n][2] + acc[m][n][3] * acc[m][n][3];
      ss += __shfl_xor(ss, 16); ss += __shfl_xor(ss, 32);
      const float rinv = rsqrtf(ss * (1.f / 64.f) + EPSV);
      bf16_t* dp = P.Kb + ((size_t)b * 4352 + 4096 + j) * 768 + nb + quad * 4;
#pragma unroll
      for (int n = 0; n < 4; ++n) store4_bf16(dp + n * 16, acc[m][n] * rinv * gv[n]);
    }
  } else {
    const int id = u - 1432, mt = id >> 2, nt = id & 3;
    gemm_mainloop(lds, P.wt_in0 + (size_t)(1536 + mt * 128 + lr) * 1024 + lc, P.wt_in0 + (size_t)(1536 + mt * 128 + 64 + lr) * 1024 + lc, P.HC + (size_t)(nt * 256 + lr) * 1024 + lc, 1024, 1024, acc);
#pragma unroll
    for (int m = 0; m < 4; ++m) {
      const int c = mt * 128 + wm * 64 + m * 16 + l15;
#pragma unroll
      for (int n = 0; n < 4; ++n) {
        const int rr = nt * 256 + wn * 64 + n * 16 + quad * 4, b = rr >> 8, j = rr & 255;
        store4_bf16(P.Vt + ((size_t)b * 768 + c) * 4352 + 4096 + (j & ~31) + quad * 8 + (n & 1) * 4, acc[m][n]);
      }
    }
  }
}

__device__ void dft_unit(const Params& P, char* lds, int id) {
  GEMM_PRE();
  const int b = id >> 4, mt = id & 15;
  const bf16_t* Bt = P.Zt + (size_t)b * 256 * 8192;
  gemm_mainloop(lds, P.dft + (size_t)(mt * 128 + lr) * 8192 + lc, P.dft + (size_t)(mt * 128 + 64 + lr) * 8192 + lc, Bt + (size_t)lr * 8192 + lc, 8192, 4096, acc);
  float* park = (float*)P.A2 + (size_t)id * 32768 + (size_t)tid * 4;
#pragma unroll
  for (int m = 0; m < 4; ++m)
#pragma unroll
    for (int n = 0; n < 4; ++n) *(f32x4*)(park + (m * 4 + n) * 2048) = acc[m][n];
  gemm_mainloop(lds, P.dft + (size_t)(mt * 128 + lr) * 8192 + 4096 + lc, P.dft + (size_t)(mt * 128 + 64 + lr) * 8192 + 4096 + lc, Bt + (size_t)lr * 8192 + 4096 + lc, 8192, 4096, acc);
#pragma unroll
  for (int m = 0; m < 4; ++m) {
    const int k = mt * 128 + wm * 64 + m * 16 + l15;
#pragma unroll
    for (int n = 0; n < 4; ++n) {
      const int col = 768 + wn * 64 + n * 16 + quad * 4;
      const f32x4 uu = *(const f32x4*)(park + (m * 4 + n) * 2048);
      store4_bf16(P.OCAT + ((size_t)b * 4096 + k) * 1024 + col, (uu + acc[m][n]) * (1.f / 512.f));
      if (k > 0) store4_bf16(P.OCAT + ((size_t)b * 4096 + (4096 - k)) * 1024 + col, (uu - acc[m][n]) * (1.f / 512.f));
    }
  }
}
__device__ void dft_nyquist_unit(const Params& P, int b) {
  const int tid = otid();
  const int cp = tid >> 1, half = tid & 1;
  const bf16_t* src = P.Zt + ((size_t)b * 256 + cp) * 8192 + half * 2048;
  float se = 0.f, so = 0.f;
#pragma unroll 8
  for (int i = 0; i < 256; ++i) {
    const u32x4 w = *(const u32x4*)(src + i * 8);
#pragma unroll
    for (int j = 0; j < 4; ++j) { se += __uint_as_float(w[j] << 16); so += __uint_as_float(w[j] & 0xffff0000u); }
  }
  float v = se - so;
  v += __shfl_xor(v, 1);
  if (half == 0) P.OCAT[((size_t)b * 4096 + 2048) * 1024 + 768 + cp] = (bf16_t)(pk_bf16(v * (1.f / 512.f), 0.f) & 0xffffu);
}

__device__ void outproj_unit(const Params& P, char* lds, int u, const bf16_t* Wt, const float* xin, int l) {
  GEMM_PRE();
  const int mt = u >> 2, nt = u & 3;
  gemm_mainloop(lds, P.OCAT + (size_t)(mt * 128 + lr) * 1024 + lc, P.OCAT + (size_t)(mt * 128 + 64 + lr) * 1024 + lc, Wt + (size_t)(nt * 256 + lr) * 1024 + lc, 1024, 1024, acc);
#pragma unroll
  for (int m = 0; m < 4; ++m) {
    const int t = mt * 128 + wm * 64 + m * 16 + l15, b = t >> 12;
#pragma unroll
    for (int n = 0; n < 4; ++n) {
      const int c = nt * 256 + wn * 64 + n * 16 + quad * 4;
      const f32x4 g = *(const f32x4*)(P.mods + ((size_t)l * 5 + b) * 6144 + 2048 + c);
      const f32x4 xv = xin ? *(const f32x4*)(xin + (size_t)t * 1024 + c) : load4_bf16(P.XB + (size_t)t * 1024 + c);
      store4_bf16(P.XB + (size_t)t * 1024 + c, xv + g * acc[m][n]);
    }
  }
}

__device__ __forceinline__ float silu_f(float v) { return v / (1.f + __expf(-v)); }

__device__ void moe_gu_unit(const Params& P, char* lds, int u, int l) {
  GEMM_PRE();
  const int mt = u & 3, b = (u >> 2) & 3, nt = (u >> 4) & 7, e = u >> 7, be = b * 16 + e;
  const int tok = P.idx[be * 512 + mt * 128 + lr], tok1 = P.idx[be * 512 + mt * 128 + 64 + lr];
  const bf16_t* Wt = P.wt_gu + ((size_t)(l * 16 + e) * 2048 + nt * 256) * 1024;
  gemm_mainloop(lds, P.H + ((size_t)b * 4096 + tok) * 1024 + lc, P.H + ((size_t)b * 4096 + tok1) * 1024 + lc, Wt + (size_t)lr * 1024 + lc, 1024, 1024, acc);
#pragma unroll
  for (int m = 0; m < 4; ++m) {
    const int rl = mt * 128 + wm * 64 + m * 16 + l15;
    bf16_t* dp = P.A2 + ((size_t)be * 512 + rl) * 1024 + nt * 128 + wn * 32 + quad * 4;
#pragma unroll
    for (int pp = 0; pp < 2; ++pp) {
      f32x4 a;
#pragma unroll
      for (int r = 0; r < 4; ++r) a[r] = silu_f(acc[m][2 * pp][r]) * acc[m][2 * pp + 1][r];
      store4_bf16(dp + pp * 16, a);
    }
  }
}

__device__ void moe_down_unit(const Params& P, char* lds, int u, int l) {
  GEMM_PRE();
  const int mt = u & 3, b = (u >> 2) & 3, nt = (u >> 4) & 3, e = u >> 6, be = b * 16 + e;
  const bf16_t* Wt = P.wt_d + ((size_t)(l * 16 + e) * 1024 + nt * 256) * 1024;
  gemm_mainloop(lds, P.A2 + ((size_t)be * 512 + mt * 128 + lr) * 1024 + lc, P.A2 + ((size_t)be * 512 + mt * 128 + 64 + lr) * 1024 + lc, Wt + (size_t)lr * 1024 + lc, 1024, 1024, acc);
#pragma unroll
  for (int m = 0; m < 4; ++m) {
    const int rl = mt * 128 + wm * 64 + m * 16 + l15;
    bf16_t* yp = P.Y + ((size_t)be * 512 + rl) * 1024 + nt * 256 + wn * 64 + quad * 4;
#pragma unroll
    for (int n = 0; n < 4; ++n) store4_bf16(yp + n * 16, acc[m][n]);
  }
}

__device__ void convin_unit(const Params& P, char* lds, int u) {
  GEMM_PRE();
  const int mt = u / 12, nt = u % 12;
  const bf16_t* Wt = P.wt_cin + (size_t)nt * 256 * 1024;
  gemm_mainloop(lds, P.H + (size_t)(mt * 128 + lr) * 1024 + lc, P.H + (size_t)(mt * 128 + 64 + lr) * 1024 + lc, Wt + (size_t)lr * 1024 + lc, 1024, 1024, acc);
#pragma unroll
  for (int m = 0; m < 4; ++m) {
    const int t = mt * 128 + wm * 64 + m * 16 + l15;
    if (nt < 8) {
      bf16_t* dp = P.Zc + (size_t)t * 1024 + nt * 128 + wn * 32 + quad * 4;
      store4_bf16(dp, acc[m][0] * acc[m][1]);
      store4_bf16(dp + 16, acc[m][2] * acc[m][3]);
    } else {
      bf16_t* dp = P.BG + (size_t)t * 1024 + (nt - 8) * 256 + wn * 64 + quad * 4;
#pragma unroll
      for (int n = 0; n < 4; ++n) store4_bf16(dp + n * 16, acc[m][n]);
    }
  }
}

__device__ void attn_unit(const Params& P, char* lds, int u) {
  const int tid = otid(), lane = tid & 63, wave = tid >> 6, l15 = lane & 15, quad = lane >> 4;
  const int qg = wave & 3, sm = wave >> 2;
  const int qblk = u & 31, h = (u >> 5) % 6, b = u / 192;
  const int q0 = qblk * 128 + qg * 32;
  float lam;
  {
    const float a = wave_sum(P.lam_q1[lane] * P.lam_k1[lane]), c = wave_sum(P.lam_q2[lane] * P.lam_k2[lane]);
    lam = __expf(a) - __expf(c) + 0.2f;
  }
  float negM;
  {
    float gq = fabsf(P.q_norm[lane]), gk = fabsf(P.k_norm[lane]);
#pragma unroll
    for (int o_ = 32; o_ > 0; o_ >>= 1) { gq = fmaxf(gq, __shfl_xor(gq, o_)); gk = fmaxf(gk, __shfl_xor(gk, o_)); }
    negM = -(gq * gk * (8.f * 1.44269504f) * 1.02f + 0.5f);
  }
  bf16x8 qf[2][2];
#pragma unroll
  for (int qb = 0; qb < 2; ++qb)
#pragma unroll
    for (int ds = 0; ds < 2; ++ds)
      qf[qb][ds] = *(const bf16x8*)(P.Q + (size_t)(b * 4096 + q0 + qb * 16 + l15) * 768 + h * 128 + sm * 64 + ds * 32 + quad * 8);
  f32x4 o[8][2];
#pragma unroll
  for (int eb = 0; eb < 8; ++eb) { o[eb][0] = (f32x4){0.f, 0.f, 0.f, 0.f}; o[eb][1] = (f32x4){0.f, 0.f, 0.f, 0.f}; }
  f32x4 lsum[2] = {(f32x4){0.f, 0.f, 0.f, 0.f}, (f32x4){0.f, 0.f, 0.f, 0.f}};
  const bf16x8 ones8 = {(short)0x3F80, (short)0x3F80, (short)0x3F80, (short)0x3F80, (short)0x3F80, (short)0x3F80, (short)0x3F80, (short)0x3F80};
  const int kkey = tid >> 3, gch = (tid & 7) ^ ((tid >> 4) & 7);
  const bf16_t* kp0 = P.Kb + ((size_t)b * 4352 + kkey) * 768 + h * 128 + gch * 8;
  const bf16_t* vp0 = P.Vt + ((size_t)b * 768 + h * 128 + kkey) * 4352 + gch * 8;
  const bf16_t* vp1 = vp0 + (size_t)64 * 4352;
  char* lw = lds + __builtin_amdgcn_readfirstlane(wave) * 1024;
  glds16(kp0, lw); glds16(kp0 + 64, lw + 8192); glds16(vp0, lw + 16384); glds16(vp1, lw + 24576);
  __syncthreads();
  const int NT = 68;
  int koff[2], voff[2][2];
#pragma unroll
  for (int ds = 0; ds < 2; ++ds) koff[ds] = l15 * 128 + (((ds * 4 + quad) ^ ((l15 >> 1) & 7)) * 16);
#pragma unroll
  for (int ks = 0; ks < 2; ++ks) {
    const int c0 = ks * 4 + (quad >> 1), c1 = c0 + 2, wi = (quad & 1) * 8;
    voff[ks][0] = l15 * 128 + ((c0 ^ (l15 & 7)) * 16) + wi;
    voff[ks][1] = l15 * 128 + ((c1 ^ (l15 & 7)) * 16) + wi;
  }
  for (int kt = 0; kt < NT; ++kt) {
    const int cur = kt & 1;
    const bool more = kt + 1 < NT;
    if (more) {
      const size_t ko = (size_t)(kt + 1) * 64 * 768;
      char* nb = lw + (cur ^ 1) * 32768;
      glds16(kp0 + ko, nb); glds16(kp0 + ko + 64, nb + 8192); glds16(vp0 + (kt + 1) * 64, nb + 16384); glds16(vp1 + (kt + 1) * 64, nb + 24576);
    }
    const char* Ks = lds + cur * 32768 + sm * 8192;
    const char* Vs = lds + cur * 32768 + 16384;
    f32x4 s[4][2];
#pragma unroll
    for (int kb = 0; kb < 4; ++kb) { s[kb][0] = (f32x4){negM, negM, negM, negM}; s[kb][1] = (f32x4){negM, negM, negM, negM}; }
#pragma unroll
    for (int kb = 0; kb < 4; ++kb)
#pragma unroll
      for (int ds = 0; ds < 2; ++ds) {
        const bf16x8 kf = *(const bf16x8*)(Ks + koff[ds] + kb * 2048);
        s[kb][0] = mfma16(kf, qf[0][ds], s[kb][0]);
        s[kb][1] = mfma16(kf, qf[1][ds], s[kb][1]);
      }
    bf16x8 pf[2][2];
    __builtin_amdgcn_sched_barrier(0);
#pragma unroll
    for (int qb = 0; qb < 2; ++qb) {
#pragma unroll
      for (int kb = 0; kb < 4; ++kb)
#pragma unroll
        for (int r = 0; r < 4; ++r) s[kb][qb][r] = __builtin_amdgcn_exp2f(s[kb][qb][r]);
#pragma unroll
      for (int ks = 0; ks < 2; ++ks) {
        u32x4 w;
        w.x = pk_bf16(s[2 * ks][qb][0], s[2 * ks][qb][1]); w.y = pk_bf16(s[2 * ks][qb][2], s[2 * ks][qb][3]);
        w.z = pk_bf16(s[2 * ks + 1][qb][0], s[2 * ks + 1][qb][1]); w.w = pk_bf16(s[2 * ks + 1][qb][2], s[2 * ks + 1][qb][3]);
        pf[qb][ks] = __builtin_bit_cast(bf16x8, w);
      }
    }
    __builtin_amdgcn_sched_barrier(0);
#pragma unroll
    for (int ks = 0; ks < 2; ++ks) { lsum[0] = mfma16(ones8, pf[0][ks], lsum[0]); lsum[1] = mfma16(ones8, pf[1][ks], lsum[1]); }
#pragma unroll
    for (int eb = 0; eb < 8; ++eb)
#pragma unroll
      for (int ks = 0; ks < 2; ++ks) {
        const bf16x8 vf = *(const bf16x8*)(Vs + koff[ks] + eb * 2048);
        o[eb][0] = mfma16(vf, pf[0][ks], o[eb][0]);
        o[eb][1] = mfma16(vf, pf[1][ks], o[eb][1]);
        if (ks == 1 && (eb & 1)) __builtin_amdgcn_sched_barrier(0);
      }
    __builtin_amdgcn_sched_barrier(0);
    __syncthreads();
  }
#pragma unroll
  for (int qb = 0; qb < 2; ++qb) {
    const float inv = 1.f / lsum[qb][0];
#pragma unroll
    for (int eb = 0; eb < 8; ++eb) o[eb][qb] *= inv;
  }
  float* comb = (float*)lds;
  if (sm == 1) {
#pragma unroll
    for (int eb = 0; eb < 8; ++eb)
#pragma unroll
      for (int qb = 0; qb < 2; ++qb)
#pragma unroll
        for (int r = 0; r < 4; ++r) comb[(qg * 64 + eb * 8 + qb * 4 + r) * 64 + lane] = o[eb][qb][r];
  }
  __syncthreads();
  if (sm == 0) {
#pragma unroll
    for (int qb = 0; qb < 2; ++qb) {
      float ss = 0.f;
#pragma unroll
      for (int eb = 0; eb < 8; ++eb)
#pragma unroll
        for (int r = 0; r < 4; ++r) { const float v = o[eb][qb][r] - lam * comb[(qg * 64 + eb * 8 + qb * 4 + r) * 64 + lane]; o[eb][qb][r] = v; ss += v * v; }
      ss += __shfl_xor(ss, 16); ss += __shfl_xor(ss, 32);
      const float rinv = rsqrtf(ss * (1.f / 128.f) + EPSV) * 0.8f;
      bf16_t* dp = P.OCAT + (size_t)(b * 4096 + q0 + qb * 16 + l15) * 1024 + h * 128 + quad * 4;
#pragma unroll
      for (int eb = 0; eb < 8; ++eb) {
        const f32x4 g = *(const f32x4*)(P.subln + eb * 16 + quad * 4);
        store4_bf16(dp + eb * 16, o[eb][qb] * rinv * g);
      }
    }
  }
}


#define XB_TMO      128
#define XB_XCNT(j)  (256  + 64 * (j))
#define XB_XSUB(j)  (1280 + 64 * (j))
#define XB_XGEN(j)  (2304 + 64 * (j))
#define XB_TOP      3328
#define XB_TOPGEN   3392
#define XCD_BAR_WORDS 3456
#define XB_SPIN_CAP (1u << 18)
#define LAS __attribute__((address_space(3)))
__device__ __forceinline__ unsigned xb_ld(unsigned* p)              { return __hip_atomic_load(p, __ATOMIC_RELAXED, __HIP_MEMORY_SCOPE_AGENT); }
__device__ __forceinline__ unsigned xb_add(unsigned* p, unsigned v) { return __hip_atomic_fetch_add(p, v, __ATOMIC_RELAXED, __HIP_MEMORY_SCOPE_AGENT); }
__device__ __forceinline__ unsigned xb_xcc_id() { return (unsigned)__builtin_amdgcn_s_getreg((3 << 11) | 20) & 0xFu; }
#define XB_SPIN(cond, bar) do { unsigned _sp = 0; while (cond) { __builtin_amdgcn_s_sleep(1); \
    if ((++_sp & 255u) == 0u) { if (xb_ld(&(bar)[XB_TMO])) break; if (_sp > XB_SPIN_CAP) { atomicAdd(&(bar)[XB_TMO], 1u); break; } } } } while (0)
struct XcdBarrier { unsigned* bar; unsigned x; volatile LAS unsigned* st; };
__device__ __forceinline__ XcdBarrier xcd_barrier_post(unsigned* bar, volatile LAS unsigned* st) {
    XcdBarrier b; b.bar = bar; b.x = xb_xcc_id(); b.st = st;
    if (threadIdx.x == 0) (void)xb_add(&bar[XB_XCNT(b.x)], 1u);
    return b;
}
__device__ __forceinline__ void xcd_barrier_complete(unsigned* bar, unsigned x, unsigned& nloc, unsigned& nx) {
    const unsigned G = gridDim.x * gridDim.y * gridDim.z;
    unsigned sum, cnt, mine, sp = 0u;
    for (;;) {
        sum = 0u; cnt = 0u; mine = 0u;
#pragma unroll
        for (unsigned j = 0; j < 16; ++j) { const unsigned c = xb_ld(&bar[XB_XCNT(j)]); sum += c; cnt += (c > 0u) ? 1u : 0u; mine = (j == x) ? c : mine; }
        if (sum == G) break;
        __builtin_amdgcn_s_sleep(1);
        if ((++sp & 255u) == 0u) { if (xb_ld(&bar[XB_TMO])) break; if (sp > XB_SPIN_CAP) { atomicAdd(&bar[XB_TMO], 1u); break; } }
    }
    nloc = mine > 0u ? mine : 1u; nx = cnt > 0u ? cnt : 1u;
}
__device__ __forceinline__ void xcd_barrier(const XcdBarrier& b) {
    asm volatile("s_waitcnt vmcnt(0)" ::: "memory");
    __syncthreads();
    if (threadIdx.x == 0) {
        unsigned* bar = b.bar;
        __builtin_amdgcn_s_waitcnt(0);
        unsigned nloc = b.st[0], nx = b.st[1];
        if (nloc == 0u) { xcd_barrier_complete(bar, b.x, nloc, nx); b.st[0] = nloc; b.st[1] = nx; }
        const unsigned old = xb_add(&bar[XB_XSUB(b.x)], 1u);
        const unsigned gen = old / nloc;
        if (old + 1u == (gen + 1u) * nloc) {
            __builtin_amdgcn_fence(__ATOMIC_RELEASE, "agent");
            asm volatile("s_waitcnt vmcnt(0)" ::: "memory");
            const unsigned og = xb_add(&bar[XB_TOP], 1u);
            const unsigned tg = og / nx;
            if (og + 1u == (tg + 1u) * nx) xb_add(&bar[XB_TOPGEN], 1u);
            else XB_SPIN(xb_ld(&bar[XB_TOPGEN]) == tg, bar);
            __builtin_amdgcn_fence(__ATOMIC_ACQUIRE, "agent");
            xb_add(&bar[XB_XGEN(b.x)], 1u);
            asm volatile("s_waitcnt vmcnt(0)" ::: "memory");
        } else {
            XB_SPIN(xb_ld(&bar[XB_XGEN(b.x)]) == gen, bar);
            __builtin_amdgcn_fence(__ATOMIC_ACQUIRE, "agent");
            asm volatile("s_waitcnt vmcnt(0)" ::: "memory");
        }
    }
    __syncthreads();
}

__global__ void __launch_bounds__(NTHREADS) fwd_megakernel(Params P) {
  extern __shared__ __attribute__((aligned(16))) char lds[];
  int* s_unit_p = (int*)(lds + LDS_BYTES);
  int u;
  volatile LAS unsigned* xst = (volatile LAS unsigned*)(lds + LDS_BYTES + 16);
  if (threadIdx.x == 0) { xst[0] = 0u; xst[1] = 0u; }
  __syncthreads();
  const XcdBarrier xb = xcd_barrier_post(P.counters, xst);
#define PHASE_BEGIN(k) if (P.phase_lo <= (k) && (k) < P.phase_hi) { if ((k) > P.phase_lo) xcd_barrier(xb); unsigned* ctr = P.counters + (k); (void)ctr;
#define PHASE_END }
  const int ubase = (int)((blockIdx.x & 7u) * (gridDim.x >> 3) + (blockIdx.x >> 3));
#define FOR_UNITS(N) for (u = ubase; u < (N); u += gridDim.x)
#define USYNC __syncthreads();
  PHASE_BEGIN(0)
    FOR_UNITS(P0_GEMV + P0_DFT + P0_FOLD + P0_ROPE) {
      USYNC
      if (u < P0_GEMV) p0_gemv(P, lds, u);
      else if (u < P0_GEMV + P0_DFT) p0_dft(P, lds, u - P0_GEMV);
      else if (u < P0_GEMV + P0_DFT + P0_FOLD) p0_fold(P, lds, u - P0_GEMV - P0_DFT);
      else p0_rope(P);
    }
    USYNC
    cvt_stream(P, lds, u - (P0_GEMV + P0_DFT + P0_FOLD + P0_ROPE), (int)gridDim.x, P0_CVT);
  PHASE_END
  PHASE_BEGIN(1) for (int rep = 0; rep < DBG_REPS; ++rep) phase_modulate(P, P.x, 0, true, -1); PHASE_END
  PHASE_BEGIN(2)
    int q_;
    while ((q_ = next_unit(ctr, s_unit_p)) < 762 * 3 + 6) {
      if (q_ >= 762 * 3 || (q_ % 3) == 2) {
        const int cg_ = (q_ >= 762 * 3) ? (762 + (q_ - 762 * 3)) : (q_ / 3);
        cvt_stream(P, lds, CVT_SMALL + cg_ * 4, 1, CVT_SMALL + cg_ * 4 + 4);
        continue;
      }
      u = (q_ / 3) * 2 + (q_ % 3);
      if (u >= 256 && u < 324) {
        const int bb = (u < 260) ? (u - 256) : ((u - 260) >> 4);
        if (threadIdx.x == 0) {
          unsigned sp_ = 0;
          while (xb_ld(&P.counters[32 + bb]) < 64u) { __builtin_amdgcn_s_sleep(2); if (++sp_ > (1u << 22)) break; }
          __builtin_amdgcn_fence(__ATOMIC_ACQUIRE, "agent");
          asm volatile("s_waitcnt vmcnt(0)" ::: "memory");
        }
        __syncthreads();
        if (u < 260) dft_nyquist_unit(P, u - 256); else dft_unit(P, lds, u - 260);
      } else {
        const int ou = (u < 256) ? (1152 + u) : (u < 1092) ? (u - 324) : (u < 1476) ? (768 + (u - 1092)) : (1408 + (u - 1476));
        inproj_unit(P, lds, ou);
        if (u < 256) {
          asm volatile("s_waitcnt vmcnt(0)" ::: "memory");
          __syncthreads();
          if (threadIdx.x == 0) {
            __builtin_amdgcn_fence(__ATOMIC_RELEASE, "agent");
            asm volatile("s_waitcnt vmcnt(0)" ::: "memory");
            xb_add(&P.counters[32 + ((u & 63) >> 4)], 1u);
          }
        }
      }
    }
  PHASE_END
  PHASE_BEGIN(3) FOR_UNITS(768) { USYNC attn_unit(P, lds, u); } PHASE_END
  PHASE_BEGIN(4) for (int rep = 0; rep < DBG_REPG; ++rep) FOR_UNITS(512) { USYNC outproj_unit(P, lds, u, P.wt_out0, P.x, 0); } PHASE_END
  PHASE_BEGIN(5) for (int rep = 0; rep < DBG_REP5; ++rep) phase_router(P, lds, 0); PHASE_END
#define TOPK_AND_CVT(first, count) do { if (ubase < 64) { FOR_UNITS(64) { USYNC topk_unit(P, lds, u); } } \
    else { USYNC cvt_stream(P, lds, CVT_SMALL + CVT_MOE_PER_LAYER + (first) + (ubase - 64), (int)gridDim.x - 64, CVT_SMALL + CVT_MOE_PER_LAYER + (first) + (count)); } } while (0)
  PHASE_BEGIN(6) TOPK_AND_CVT(0, CVT_MOE_PER_LAYER / 2); PHASE_END
  PHASE_BEGIN(7) for (int rep = 0; rep < DBG_REP7; ++rep) FOR_UNITS(2048) { USYNC moe_gu_unit(P, lds, u, 0); } PHASE_END
  PHASE_BEGIN(8) for (int rep = 0; rep < DBG_REPD; ++rep) FOR_UNITS(1024) { USYNC moe_down_unit(P, lds, u, 0); } PHASE_END
  PHASE_BEGIN(9) phase_modulate(P, P.out, 1, false, 0); PHASE_END
  PHASE_BEGIN(10) for (int rep = 0; rep < DBG_REPG; ++rep) FOR_UNITS(1536) { USYNC convin_unit(P, lds, u); } PHASE_END
  PHASE_BEGIN(11) for (int rep = 0; rep < DBG_REPS; ++rep) phase_conv(P); PHASE_END
  PHASE_BEGIN(12) FOR_UNITS(512) { USYNC outproj_unit(P, lds, u, P.wt_cout, (const float*)nullptr, 1); } PHASE_END
  PHASE_BEGIN(13) for (int rep = 0; rep < DBG_REP5; ++rep) phase_router(P, lds, 1); PHASE_END
  PHASE_BEGIN(14) TOPK_AND_CVT(CVT_MOE_PER_LAYER / 2, CVT_MOE_PER_LAYER - CVT_MOE_PER_LAYER / 2); PHASE_END
  PHASE_BEGIN(15) FOR_UNITS(2048) { USYNC moe_gu_unit(P, lds, u, 1); } PHASE_END
  PHASE_BEGIN(16) for (int rep = 0; rep < DBG_REPD; ++rep) FOR_UNITS(1024) { USYNC moe_down_unit(P, lds, u, 1); } PHASE_END
  PHASE_BEGIN(17) phase_combine(P, 1); PHASE_END
}

extern "C" void kernel_launch(void* const* d_in, const int* in_sizes, int n_in, void* d_out, int out_size, void* d_ws, size_t ws_size, hipStream_t stream) {
  (void)in_sizes; (void)n_in; (void)out_size; (void)ws_size;
  static int grid_blocks = 0;
  if (!grid_blocks) {
    int dev = 0, cus = 0, per_cu = 0;
    hipGetDevice(&dev);
    hipDeviceGetAttribute(&cus, hipDeviceAttributeMultiprocessorCount, dev);
    if (hipFuncSetAttribute((const void*)fwd_megakernel, hipFuncAttributeMaxDynamicSharedMemorySize, LDS_TOTAL) != hipSuccess) fprintf(stderr, "hipFuncSetAttribute failed\n");
    hipOccupancyMaxActiveBlocksPerMultiprocessor(&per_cu, (const void*)fwd_megakernel, NTHREADS, LDS_TOTAL);
    if (per_cu < 1) per_cu = 1;
    grid_blocks = cus * per_cu;
  }
  Params p{};
  const float* const* in = (const float* const*)d_in;
  p.x = in[0]; p.c = in[1]; p.ctx = in[2]; p.c_ctx = in[3]; p.ada_w = in[4]; p.ada_b = in[5]; p.norm_mix = in[6]; p.norm_ffn = in[7];
  p.attn_w_in = in[8]; p.q_norm = in[9]; p.k_norm = in[10]; p.lam_q1 = in[11]; p.lam_k1 = in[12]; p.lam_q2 = in[13]; p.lam_k2 = in[14];
  p.subln = in[15]; p.attn_w_out = in[16]; p.conv_w_in = in[17]; p.conv_w = in[18]; p.conv_w_out = in[19]; p.router_w = in[20];
  p.moe_gate = in[21]; p.moe_up = in[22]; p.moe_down = in[23];
  p.out = (float*)d_out;
  char* w = (char*)d_ws;
  size_t off = 0;
  auto take = [&](size_t bytes) { char* r = w + off; off += (bytes + 255) & ~(size_t)255; return r; };
  p.counters = (unsigned*)take(XCD_BAR_WORDS * 4);
  p.mods = (float*)take((size_t)2 * 5 * 6144 * 4);
  p.rope = (float*)take(2048 * 4);
  p.aff = (float*)take((size_t)64 * 4096 * 4);
  p.gate = (float*)take((size_t)64 * 512 * 4);
  p.idx = (int*)take((size_t)64 * 512 * 4);
  p.inv = (int*)take((size_t)16384 * 16 * 4);
  p.wt_in0 = (bf16_t*)take((size_t)2816 * 1024 * 2);
  p.wt_out0 = (bf16_t*)take((size_t)1024 * 1024 * 2);
  p.wt_cin = (bf16_t*)take((size_t)3072 * 1024 * 2);
  p.wt_cout = (bf16_t*)take((size_t)1024 * 1024 * 2);
  p.wt_gu = (bf16_t*)take((size_t)32 * 2048 * 1024 * 2);
  p.wt_d = (bf16_t*)take((size_t)32 * 1024 * 1024 * 2);
  p.dft = (bf16_t*)take((size_t)4096 * 8192 * 2);
  p.XB = (bf16_t*)take((size_t)16384 * 1024 * 2);
  p.Y = p.dft;
  p.H = (bf16_t*)take((size_t)16384 * 1024 * 2);
  p.HC = (bf16_t*)take((size_t)1024 * 1024 * 2);
  p.OCAT = (bf16_t*)take((size_t)16384 * 1024 * 2);
  p.A2 = (bf16_t*)take((size_t)64 * 512 * 1024 * 2);
  char* l0 = take((size_t)16384 * 768 * 2 + (size_t)4 * 4352 * 768 * 2 * 2 + (size_t)4 * 256 * 8192 * 2);
  p.Q = (bf16_t*)l0;
  p.Kb = (bf16_t*)(l0 + (size_t)16384 * 768 * 2);
  p.Vt = (bf16_t*)(l0 + (size_t)16384 * 768 * 2 + (size_t)4 * 4352 * 768 * 2);
  p.Zt = (bf16_t*)(l0 + (size_t)16384 * 768 * 2 + (size_t)4 * 4352 * 768 * 2 * 2);
  p.Zc = (bf16_t*)l0;
  p.BG = (bf16_t*)(l0 + (size_t)16384 * 1024 * 2);
  hipMemsetAsync(p.counters, 0, XCD_BAR_WORDS * 4, stream);
#if SINGLE_LAUNCH
  p.phase_lo = 0; p.phase_hi = DBG_PHASE_HI;
  void* args[] = {&p};
  hipError_t e = hipLaunchCooperativeKernel((void*)fwd_megakernel, dim3(grid_blocks), dim3(NTHREADS), args, LDS_TOTAL, stream);
  if (e != hipSuccess) fprintf(stderr, "cooperative launch failed: %s (grid %d)\n", hipGetErrorString(e), grid_blocks);
#else
  for (int ph = 0; ph < NPHASES; ++ph) {
    p.phase_lo = ph; p.phase_hi = ph + 1;
    fwd_megakernel<<<dim3(grid_blocks), dim3(NTHREADS), LDS_TOTAL, stream>>>(p);
  }
#endif
}
```

```cpp
#include <hip/hip_runtime.h>
#include <hip/hip_cooperative_groups.h>
#include <cstdio>
#include <cstdint>
namespace cg = cooperative_groups;

#ifndef SINGLE_LAUNCH
#define SINGLE_LAUNCH 1
#endif

typedef unsigned short bf16_t;
typedef short bf16x8 __attribute__((ext_vector_type(8)));
typedef float f32x4 __attribute__((ext_vector_type(4)));
typedef unsigned u32x4 __attribute__((ext_vector_type(4)));
typedef unsigned u32x2 __attribute__((ext_vector_type(2)));

#define NTHREADS 512
#define EPSV 1e-6f
#define NPHASES 18
#ifndef DBG_OUTK
#define DBG_OUTK 1024
#endif
#ifndef DBG_REP7
#define DBG_REP7 1
#endif
#ifndef DBG_REP3
#define DBG_REP3 1
#endif
#ifndef DBG_REP0
#define DBG_REP0 1
#endif
#ifndef DBG_REP5
#define DBG_REP5 1
#endif
#ifndef DBG_REPG
#define DBG_REPG 1
#endif
#ifndef DBG_REPS
#define DBG_REPS 1
#endif
#ifndef DBG_REPD
#define DBG_REPD 1
#endif
#ifndef DBG_PHASE_HI
#define DBG_PHASE_HI NPHASES
#endif
#define LDS_BYTES 147456
#define LDS_TOTAL (147456 + 256)

struct Params {
  const float *x, *c, *ctx, *c_ctx, *ada_w, *ada_b, *norm_mix, *norm_ffn, *attn_w_in, *q_norm, *k_norm,
      *lam_q1, *lam_k1, *lam_q2, *lam_k2, *subln, *attn_w_out, *conv_w_in, *conv_w, *conv_w_out,
      *router_w, *moe_gate, *moe_up, *moe_down;
  float* out;
  bf16_t *wt_in0, *wt_out0, *wt_cin, *wt_cout, *wt_gu, *wt_d, *dft, *H, *HC, *Q, *Kb, *Vt, *Zt, *OCAT, *A2, *Zc, *BG;
  float *mods, *rope, *aff, *gate;
  int* idx;
  int* inv;
  bf16_t* Y;
  bf16_t* XB;
  unsigned* counters;
  int phase_lo, phase_hi;
};

typedef __bf16 bf16x2_t __attribute__((ext_vector_type(2)));
typedef float f32x2_t __attribute__((ext_vector_type(2)));
__device__ __forceinline__ unsigned pk_bf16(float lo, float hi) {
  const f32x2_t v = {lo, hi};
  const bf16x2_t r = __builtin_convertvector(v, bf16x2_t);
  return __builtin_bit_cast(unsigned, r);
}
__device__ __forceinline__ float bf2f(unsigned short v) { return __uint_as_float(((unsigned)v) << 16); }
__device__ __forceinline__ float wave_sum(float v) {
#pragma unroll
  for (int o = 32; o > 0; o >>= 1) v += __shfl_xor(v, o);
  return v;
}
__device__ __forceinline__ f32x4 mfma16(bf16x8 a, bf16x8 b, f32x4 c) { return __builtin_amdgcn_mfma_f32_16x16x32_bf16(a, b, c, 0, 0, 0); }

__device__ __forceinline__ int otid() { int t = threadIdx.x; asm volatile("" : "+v"(t)); return t; }

__device__ __forceinline__ int next_unit(unsigned* ctr, int* s_unit) {
  __syncthreads();
  if (threadIdx.x == 0) *s_unit = (int)atomicAdd(ctr, 1u);
  __syncthreads();
  return *s_unit;
}

#define LASP __attribute__((address_space(3)))
__device__ __forceinline__ void glds16(const bf16_t* g, char* l) {
  __builtin_amdgcn_global_load_lds((const unsigned*)g, (LASP unsigned*)l, 16, 0, 0);
}
__device__ __forceinline__ void gemm_mainloop(char* lds, const bf16_t* pa0, const bf16_t* pa1, const bf16_t* pb, size_t ldb, int K, f32x4 (&acc)[4][4]) {
  const int tid = otid(), lane = tid & 63, wave = tid >> 6, wm = wave >> 2, wn = wave & 3, l15 = lane & 15, quad = lane >> 4;
  const int wu = __builtin_amdgcn_readfirstlane(wave);
#pragma unroll
  for (int m = 0; m < 4; ++m)
#pragma unroll
    for (int n = 0; n < 4; ++n) acc[m][n] = (f32x4){0.f, 0.f, 0.f, 0.f};
  const int nk = K >> 6;
  const bf16_t* pb1 = pb + 64 * ldb;
  const bf16_t* pb2 = pb + 128 * ldb;
  const bf16_t* pb3 = pb + 192 * ldb;
  char* lw = lds + wu * 1024;
#define GEMM_ISSUE(o, dst) do { glds16(pa0 + (o), (dst)); glds16(pa1 + (o), (dst) + 8192); glds16(pb + (o), (dst) + 16384); glds16(pb1 + (o), (dst) + 16384 + 8192); \
    glds16(pb2 + (o), (dst) + 16384 + 16384); glds16(pb3 + (o), (dst) + 16384 + 24576); } while (0)
  GEMM_ISSUE(0, lw);
  GEMM_ISSUE(64, lw + 49152);
  asm volatile("s_waitcnt vmcnt(6)" ::: "memory");
  __builtin_amdgcn_s_barrier();
  asm volatile("" ::: "memory");
  int aoff[2], boff[2];
#pragma unroll
  for (int ks = 0; ks < 2; ++ks) {
    const int sw = (((ks * 4 + quad) ^ ((l15 >> 1) & 7)) * 16);
    aoff[ks] = (wm * 64 + l15) * 128 + sw;
    boff[ks] = 16384 + (wn * 64 + l15) * 128 + sw;
  }
  bf16x8 af0[4], bf0[4], af1[4], bf1[4];
#pragma unroll
  for (int m = 0; m < 4; ++m) af0[m] = *(const bf16x8*)(lds + aoff[0] + m * 2048);
#pragma unroll
  for (int n = 0; n < 4; ++n) bf0[n] = *(const bf16x8*)(lds + boff[0] + n * 2048);
  int scur = 0;
  for (int kt = 0; kt < nk; ++kt) {
    const char* st = lds + scur * 49152;
    const bool has1 = (kt + 1 < nk), has2 = (kt + 2 < nk);
    int s1 = scur + 1; if (s1 >= 3) s1 -= 3;
    if (has2) {
      int s2 = scur + 2; if (s2 >= 3) s2 -= 3;
      char* nx = lw + s2 * 49152;
      const int o = (kt + 2) * 64;
      GEMM_ISSUE(o, nx);
    }
#pragma unroll
    for (int m = 0; m < 4; ++m) af1[m] = *(const bf16x8*)(st + aoff[1] + m * 2048);
#pragma unroll
    for (int n = 0; n < 4; ++n) bf1[n] = *(const bf16x8*)(st + boff[1] + n * 2048);
    __builtin_amdgcn_sched_barrier(0);
#pragma unroll
    for (int m = 0; m < 4; ++m)
#pragma unroll
      for (int n = 0; n < 4; ++n) acc[m][n] = mfma16(bf0[n], af0[m], acc[m][n]);
    __builtin_amdgcn_sched_barrier(0);
    if (has2) asm volatile("s_waitcnt vmcnt(6) lgkmcnt(0)" ::: "memory"); else asm volatile("s_waitcnt vmcnt(0) lgkmcnt(0)" ::: "memory");
    __builtin_amdgcn_s_barrier();
    asm volatile("" ::: "memory");
    if (has1) {
      const char* sn = lds + s1 * 49152;
#pragma unroll
      for (int m = 0; m < 4; ++m) af0[m] = *(const bf16x8*)(sn + aoff[0] + m * 2048);
#pragma unroll
      for (int n = 0; n < 4; ++n) bf0[n] = *(const bf16x8*)(sn + boff[0] + n * 2048);
    }
    __builtin_amdgcn_sched_barrier(0);
#pragma unroll
    for (int m = 0; m < 4; ++m)
#pragma unroll
      for (int n = 0; n < 4; ++n) acc[m][n] = mfma16(bf1[n], af1[m], acc[m][n]);
    __builtin_amdgcn_sched_barrier(0);
    scur = s1;
  }
  asm volatile("s_waitcnt lgkmcnt(0)" ::: "memory");
  __builtin_amdgcn_s_barrier();
  asm volatile("" ::: "memory");
#undef GEMM_ISSUE
}

__device__ __forceinline__ f32x4 load4_bf16(const bf16_t* p) {
  const u32x2 w = *(const u32x2*)p;
  return (f32x4){__uint_as_float(w.x << 16), __uint_as_float(w.x & 0xffff0000u), __uint_as_float(w.y << 16), __uint_as_float(w.y & 0xffff0000u)};
}
__device__ __forceinline__ void store4_bf16(bf16_t* p, f32x4 v) {
  u32x2 w;
  w.x = pk_bf16(v[0], v[1]);
  w.y = pk_bf16(v[2], v[3]);
  *(u32x2*)p = w;
}

#define P0_GEMV 384
#define P0_DFT 256
#define P0_FOLD 128
#define P0_ROPE 1
#define P0_CVT CVT_SMALL
#define P0_TOTAL (P0_GEMV + P0_DFT + P0_FOLD + P0_ROPE + P0_CVT)

__device__ void p0_gemv(const Params& P, char* lds, int u) {
  const int tid = otid();
  const int l = u / 192, cb = u % 192, col0 = cb * 32;
  float* sc = (float*)lds;
  float* red = (float*)(lds + 20480);
  for (int i = tid; i < 5 * 1024; i += NTHREADS) {
    const int r = i >> 10, k = i & 1023;
    const float v = (r < 4) ? P.c[r * 1024 + k] : P.c_ctx[k];
    sc[i] = v / (1.f + __expf(-v));
  }
  __syncthreads();
  const int col = tid & 31, kp = tid >> 5;
  float a0 = 0.f, a1 = 0.f, a2 = 0.f, a3 = 0.f, a4 = 0.f;
  const float* w = P.ada_w + ((size_t)l * 1024 + kp * 64) * 6144 + col0 + col;
#pragma unroll 16
  for (int k = 0; k < 64; ++k) {
    const float wv = w[(size_t)k * 6144];
    const int kk = kp * 64 + k;
    a0 += sc[kk] * wv; a1 += sc[1024 + kk] * wv; a2 += sc[2048 + kk] * wv; a3 += sc[3072 + kk] * wv; a4 += sc[4096 + kk] * wv;
  }
  red[(kp * 5 + 0) * 32 + col] = a0; red[(kp * 5 + 1) * 32 + col] = a1; red[(kp * 5 + 2) * 32 + col] = a2;
  red[(kp * 5 + 3) * 32 + col] = a3; red[(kp * 5 + 4) * 32 + col] = a4;
  __syncthreads();
  if (tid < 160) {
    const int r = tid >> 5, cc = tid & 31;
    float sum = 0.f;
#pragma unroll
    for (int q = 0; q < 16; ++q) sum += red[(q * 5 + r) * 32 + cc];
    P.mods[((size_t)l * 5 + r) * 6144 + col0 + cc] = sum + P.ada_b[l * 6144 + col0 + cc];
  }
}

__device__ void p0_dft(const Params& P, char* lds, int u) {
  const int tid = otid();
  float* tab = (float*)lds;
  for (int i = tid; i < 4096; i += NTHREADS) tab[i] = cospif((float)i * (1.f / 2048.f));
  __syncthreads();
  for (int kr = 0; kr < 8; ++kr) {
    const int k = u * 8 + kr;
    unsigned cw[4], sw[4];
#pragma unroll
    for (int i = 0; i < 4; ++i) {
      const int n0 = tid * 8 + 2 * i;
      const int p0 = (k * n0) & 4095, p1 = (k * (n0 + 1)) & 4095;
      cw[i] = pk_bf16(tab[p0], tab[p1]);
      sw[i] = pk_bf16(tab[(p0 + 1024) & 4095], tab[(p1 + 1024) & 4095]);
    }
    *(u32x4*)(P.dft + (size_t)k * 8192 + tid * 8) = (u32x4){cw[0], cw[1], cw[2], cw[3]};
    *(u32x4*)(P.dft + (size_t)k * 8192 + 4096 + tid * 8) = (u32x4){sw[0], sw[1], sw[2], sw[3]};
  }
}

__device__ void p0_fold(const Params& P, char* lds, int u) {
  const int tid = otid();
  float* tab = (float*)lds;
  float* wl = (float*)(lds + 256);
  const int k0 = u * 8;
  if (tid < 64) tab[tid] = cospif((float)tid * (1.f / 32.f));
  {
    const int r = tid >> 6, c4 = (tid & 63) * 4;
    *(f32x4*)(wl + r * 256 + c4) = *(const f32x4*)(P.attn_w_in + (size_t)(k0 + r) * 2560 + 2304 + c4);
  }
  __syncthreads();
  const int col = tid & 255, kh = tid >> 8, g = col >> 6, cp = col & 63;
  float sa[4] = {0.f, 0.f, 0.f, 0.f}, sb[4] = {0.f, 0.f, 0.f, 0.f};
#pragma unroll 4
  for (int c = 0; c < 64; ++c) {
    const int ph = (c * cp) & 63;
    const float tc = tab[ph], ts = tab[(ph + 48) & 63];
#pragma unroll
    for (int j = 0; j < 4; ++j) { const float w = wl[(kh * 4 + j) * 256 + g * 64 + c]; sa[j] += w * tc; sb[j] += w * ts; }
  }
  u32x2 wa, wb;
  wa.x = pk_bf16(sa[0], sa[1]); wa.y = pk_bf16(sa[2], sa[3]); wb.x = pk_bf16(sb[0], sb[1]); wb.y = pk_bf16(sb[2], sb[3]);
  *(u32x2*)(P.wt_in0 + (size_t)(2304 + col) * 1024 + k0 + kh * 4) = wa;
  *(u32x2*)(P.wt_in0 + (size_t)(2560 + col) * 1024 + k0 + kh * 4) = wb;
}

__device__ void p0_rope(const Params& P) {
  for (int i = threadIdx.x; i < 1024; i += NTHREADS) {
    const int pos = i >> 4, j = i & 15;
    const float inv = powf(10000.f, -(float)j / 16.f);
    const float ang = (float)pos * inv;
    P.rope[i] = cosf(ang);
    P.rope[1024 + i] = sinf(ang);
  }
}

#define CVT_SMALL 464
#define CVT_GU_PER 128
#define CVT_D_PER 64
#define CVT_MOE_PER_LAYER (16 * (CVT_GU_PER + CVT_D_PER))
__device__ __forceinline__ void cvt_decode(const Params& P, int t, int tid, const float*& sp, int& ld, bf16_t*& dp) {
  const float *p0, *p1;
  bf16_t* dst;
  int type;
  if (t < 144) { p0 = P.attn_w_in; p1 = p0; dst = P.wt_in0; ld = 2560; type = 0; }
  else if (t < 208) { t -= 144; p0 = P.attn_w_out; p1 = p0; dst = P.wt_out0; ld = 1024; type = 0; }
  else if (t < 336) { t -= 208; p0 = P.conv_w_in + 1024; p1 = P.conv_w_in + 2048; dst = P.wt_cin; ld = 3072; type = 1; }
  else if (t < 400) { t -= 336; p0 = P.conv_w_in; p1 = p0; dst = P.wt_cin + (size_t)2048 * 1024; ld = 3072; type = 0; }
  else if (t < 464) { t -= 400; p0 = P.conv_w_out; p1 = p0; dst = P.wt_cout; ld = 1024; type = 0; }
  else {
    t -= 464;
    const int layer = t / CVT_MOE_PER_LAYER; t -= layer * CVT_MOE_PER_LAYER;
    if (t < 16 * CVT_GU_PER) { const int mat = layer * 16 + t / CVT_GU_PER; t %= CVT_GU_PER; p0 = P.moe_gate + (size_t)mat * 1048576; p1 = P.moe_up + (size_t)mat * 1048576;
      dst = P.wt_gu + (size_t)mat * 2048 * 1024; ld = 1024; type = 1; }
    else { t -= 16 * CVT_GU_PER; const int mat = layer * 16 + t / CVT_D_PER; t %= CVT_D_PER; p0 = P.moe_down + (size_t)mat * 1048576; p1 = p0; dst = P.wt_d + (size_t)mat * 1048576; ld = 1024; type = 0; }
  }
  const int rb = t >> 2, kq = t & 3;
  {
    const int k = tid >> 3, ch = tid & 7;
    const int r = rb * 64 + ch * 8;
    const float* src;
    int col;
    if (type == 0) { src = p0; col = r; }
    else { const int j = r >> 8, q = (r & 255) >> 4, w = r & 15; col = j * 128 + (q >> 1) * 16 + w; src = (q & 1) ? p1 : p0; }
    sp = src + (size_t)(kq * 256 + k) * ld + col;
  }
  {
    const int n = tid >> 3, kc = tid & 7;
    dp = dst + (size_t)(rb * 64 + n) * 1024 + kq * 256 + kc * 8;
  }
}
__device__ __forceinline__ void cvt_load(const float* sp, int ld, f32x4 (&v)[4][2]) {
#pragma unroll
  for (int sb = 0; sb < 4; ++sb) { v[sb][0] = *(const f32x4*)(sp + (size_t)sb * 64 * ld); v[sb][1] = *(const f32x4*)(sp + (size_t)sb * 64 * ld + 4); }
}
__device__ __forceinline__ void cvt_finish(char* lds, int tid, bf16_t* dp, const f32x4 (&v)[4][2]) {
  float* tile = (float*)lds;
  {
    const int k = tid >> 3, ch = tid & 7;
#pragma unroll
    for (int sb = 0; sb < 4; ++sb) {
      float* tp = tile + sb * 4160 + k * 65 + ch * 8;
      tp[0] = v[sb][0][0]; tp[1] = v[sb][0][1]; tp[2] = v[sb][0][2]; tp[3] = v[sb][0][3]; tp[4] = v[sb][1][0]; tp[5] = v[sb][1][1]; tp[6] = v[sb][1][2]; tp[7] = v[sb][1][3];
    }
  }
  __syncthreads();
  {
    const int n = tid >> 3, kc = tid & 7;
#pragma unroll
    for (int sb = 0; sb < 4; ++sb) {
      const float* tp = tile + sb * 4160 + (kc * 8) * 65 + n;
      u32x4 w;
      w.x = pk_bf16(tp[0], tp[65]); w.y = pk_bf16(tp[130], tp[195]); w.z = pk_bf16(tp[260], tp[325]); w.w = pk_bf16(tp[390], tp[455]);
      *(u32x4*)(dp + sb * 64) = w;
    }
  }
}
__device__ __forceinline__ void cvt_stream(const Params& P, char* lds, int tfirst, int tstride, int tend) {
  const int tid = otid();
  if (tfirst >= tend) return;
  const float* sp; int ld; bf16_t* dp;
  f32x4 va[4][2], vb[4][2];
  cvt_decode(P, tfirst, tid, sp, ld, dp);
  cvt_load(sp, ld, va);
  for (int t = tfirst; t < tend; t += tstride) {
    const int tn = t + tstride;
    const bool more = tn < tend;
    bf16_t* dpn = dp;
    if (more) { const float* spn; int ldn; cvt_decode(P, tn, tid, spn, ldn, dpn); cvt_load(spn, ldn, vb); }
    __syncthreads();
    cvt_finish(lds, tid, dp, va);
    if (more) {
#pragma unroll
      for (int sb = 0; sb < 4; ++sb) { va[sb][0] = vb[sb][0]; va[sb][1] = vb[sb][1]; }
      dp = dpn;
    }
  }
}

__device__ __forceinline__ void cvt_one(const Params& P, char* lds, int t) {
  const int tid = otid();
  const float* sp; int ld; bf16_t* dp;
  f32x4 v[4][2];
  cvt_decode(P, t, tid, sp, ld, dp);
  cvt_load(sp, ld, v);
  cvt_finish(lds, tid, dp, v);
}

__device__ __forceinline__ void moe_combine_rows2(const Params& P, int l, int row0, int lane, f32x4 (&v)[2][4]) {
  const int b = row0 >> 12;
  int myslot[2];
#pragma unroll
  for (int rr = 0; rr < 2; ++rr) myslot[rr] = P.inv[(size_t)(row0 + rr) * 16 + (lane & 15)];
  f32x4 a[2][4];
  unsigned mask[2];
#pragma unroll
  for (int rr = 0; rr < 2; ++rr) {
#pragma unroll
    for (int j = 0; j < 4; ++j) a[rr][j] = (f32x4){0.f, 0.f, 0.f, 0.f};
    mask[rr] = (unsigned)(__ballot(myslot[rr] >= 0) & 0xffffull);
  }
  while (mask[0] | mask[1]) {
    int ee[2][2], sl[2][2]; float vl[2][2];
#pragma unroll
    for (int rr = 0; rr < 2; ++rr)
#pragma unroll
      for (int k = 0; k < 2; ++k) {
        if (mask[rr]) { ee[rr][k] = __builtin_ctz(mask[rr]); mask[rr] &= mask[rr] - 1u; sl[rr][k] = __builtin_amdgcn_readlane(myslot[rr], ee[rr][k]); vl[rr][k] = 1.f; }
        else { ee[rr][k] = 0; sl[rr][k] = 0; vl[rr][k] = 0.f; }
      }
    float gt[2][2]; unsigned w[2][2][4];
#pragma unroll
    for (int rr = 0; rr < 2; ++rr)
#pragma unroll
      for (int k = 0; k < 2; ++k) {
        const int be = b * 16 + ee[rr][k];
        gt[rr][k] = P.gate[be * 512 + sl[rr][k]] * vl[rr][k];
        const unsigned char* yp = (const unsigned char*)P.Y + ((size_t)be * 512 + sl[rr][k]) * 1024 + lane * 4;
#pragma unroll
        for (int j = 0; j < 4; ++j) w[rr][k][j] = *(const unsigned*)(yp + j * 256);
      }
#pragma unroll
    for (int rr = 0; rr < 2; ++rr)
#pragma unroll
      for (int k = 0; k < 2; ++k)
#pragma unroll
        for (int j = 0; j < 4; ++j) {
          const int wv_ = (int)w[rr][k][j];
          a[rr][j][0] += gt[rr][k] * __builtin_amdgcn_cvt_f32_fp8(wv_, 0); a[rr][j][1] += gt[rr][k] * __builtin_amdgcn_cvt_f32_fp8(wv_, 1);
          a[rr][j][2] += gt[rr][k] * __builtin_amdgcn_cvt_f32_fp8(wv_, 2); a[rr][j][3] += gt[rr][k] * __builtin_amdgcn_cvt_f32_fp8(wv_, 3);
        }
  }
  const float* gf = P.mods + ((size_t)l * 5 + b) * 6144 + 5120;
#pragma unroll
  for (int j = 0; j < 4; ++j) {
    const f32x4 g = *(const f32x4*)(gf + j * 256 + lane * 4);
    v[0][j] += g * a[0][j]; v[1][j] += g * a[1][j];
  }
}

__device__ void phase_combine(const Params& P, int l) {
  const int tid_ = otid(); const int lane = tid_ & 63, wave = tid_ >> 6;
  for (int row0 = (blockIdx.x * 8 + wave) * 2; row0 < 16384; row0 += gridDim.x * 16) {
    const bf16_t* src = P.XB + (size_t)row0 * 1024;
    float* dstf = P.out + (size_t)row0 * 1024;
    f32x4 v[2][4];
#pragma unroll
    for (int rr = 0; rr < 2; ++rr)
#pragma unroll
      for (int j = 0; j < 4; ++j) v[rr][j] = load4_bf16(src + rr * 1024 + j * 256 + lane * 4);
    moe_combine_rows2(P, l, row0, lane, v);
#pragma unroll
    for (int rr = 0; rr < 2; ++rr)
#pragma unroll
      for (int j = 0; j < 4; ++j) *(f32x4*)(dstf + rr * 1024 + j * 256 + lane * 4) = v[rr][j];
  }
}

__device__ void phase_modulate(const Params& P, const float* xin, int l, bool with_ctx, int comb_l) {
  const int tid_ = otid(); const int lane = tid_ & 63, wave = tid_ >> 6;
  const int nrows = with_ctx ? 17408 : 16384;
  for (int row0 = (blockIdx.x * 8 + wave) * 2; row0 < nrows; row0 += gridDim.x * 16) {
    const float* src; bf16_t* dst; int mr;
    if (row0 < 16384) { src = xin + (size_t)row0 * 1024; dst = P.H + (size_t)row0 * 1024; mr = row0 >> 12; }
    else { src = P.ctx + (size_t)(row0 - 16384) * 1024; dst = P.HC + (size_t)(row0 - 16384) * 1024; mr = 4; }
    f32x4 v[2][4];
    if (comb_l >= 0) {
#pragma unroll
      for (int rr = 0; rr < 2; ++rr)
#pragma unroll
        for (int j = 0; j < 4; ++j) v[rr][j] = load4_bf16(P.XB + (size_t)(row0 + rr) * 1024 + j * 256 + lane * 4);
      moe_combine_rows2(P, comb_l, row0, lane, v);
#pragma unroll
      for (int rr = 0; rr < 2; ++rr)
#pragma unroll
        for (int j = 0; j < 4; ++j) {
          store4_bf16(P.XB + (size_t)(row0 + rr) * 1024 + j * 256 + lane * 4, v[rr][j]);
        }
    } else {
#pragma unroll
      for (int rr = 0; rr < 2; ++rr)
#pragma unroll
        for (int j = 0; j < 4; ++j) v[rr][j] = *(const f32x4*)(src + rr * 1024 + j * 256 + lane * 4);
    }
    float rinv[2];
#pragma unroll
    for (int rr = 0; rr < 2; ++rr) {
      float ss = 0.f;
#pragma unroll
      for (int j = 0; j < 4; ++j) ss += v[rr][j][0] * v[rr][j][0] + v[rr][j][1] * v[rr][j][1] + v[rr][j][2] * v[rr][j][2] + v[rr][j][3] * v[rr][j][3];
      ss = wave_sum(ss);
      rinv[rr] = rsqrtf(ss * (1.f / 1024.f) + EPSV);
    }
    const float* md = P.mods + ((size_t)l * 5 + mr) * 6144;
#pragma unroll
    for (int j = 0; j < 4; ++j) {
      const int col = j * 256 + lane * 4;
      const f32x4 g = *(const f32x4*)(P.norm_mix + l * 1024 + col), sh = *(const f32x4*)(md + col), sc = *(const f32x4*)(md + 1024 + col);
#pragma unroll
      for (int rr = 0; rr < 2; ++rr) {
        f32x4 y;
#pragma unroll
        for (int i = 0; i < 4; ++i) y[i] = (v[rr][j][i] * rinv[rr] * g[i]) * (1.f + sc[i]) + sh[i];
        store4_bf16(dst + rr * 1024 + col, y);
      }
    }
  }
}

__device__ void phase_router(const Params& P, char* lds, int l) {
  const int tid = otid(); const int lane = tid & 63, wave = tid >> 6;
  float* wl = (float*)lds;
  __syncthreads();
  for (int i = tid; i < 4096; i += NTHREADS) {
    const int d = i >> 2, q = i & 3;
    const f32x4 w = *(const f32x4*)(P.router_w + ((size_t)l * 1024 + d) * 16 + q * 4);
    wl[(q * 4 + 0) * 1024 + d] = w[0]; wl[(q * 4 + 1) * 1024 + d] = w[1]; wl[(q * 4 + 2) * 1024 + d] = w[2]; wl[(q * 4 + 3) * 1024 + d] = w[3];
  }
  __syncthreads();
  for (int row0 = (blockIdx.x * 8 + wave) * 2; row0 < 16384; row0 += gridDim.x * 16) {
    const int b = row0 >> 12;
    f32x4 v[2][4];
    float rinv[2];
#pragma unroll
    for (int rr = 0; rr < 2; ++rr) {
      const bf16_t* src = P.XB + (size_t)(row0 + rr) * 1024;
#pragma unroll
      for (int j = 0; j < 4; ++j) v[rr][j] = load4_bf16(src + j * 256 + lane * 4);
    }
#pragma unroll
    for (int rr = 0; rr < 2; ++rr) {
      float ss = 0.f;
#pragma unroll
      for (int j = 0; j < 4; ++j) ss += v[rr][j][0] * v[rr][j][0] + v[rr][j][1] * v[rr][j][1] + v[rr][j][2] * v[rr][j][2] + v[rr][j][3] * v[rr][j][3];
      ss = wave_sum(ss);
      rinv[rr] = rsqrtf(ss * (1.f / 1024.f) + EPSV);
    }
    const float* md = P.mods + ((size_t)l * 5 + b) * 6144;
#pragma unroll
    for (int j = 0; j < 4; ++j) {
      const int col = j * 256 + lane * 4;
      const f32x4 g = *(const f32x4*)(P.norm_ffn + l * 1024 + col), sh = *(const f32x4*)(md + 3072 + col), sc = *(const f32x4*)(md + 4096 + col);
#pragma unroll
      for (int rr = 0; rr < 2; ++rr) {
#pragma unroll
        for (int i = 0; i < 4; ++i) v[rr][j][i] = (v[rr][j][i] * rinv[rr] * g[i]) * (1.f + sc[i]) + sh[i];
        store4_bf16(P.H + (size_t)(row0 + rr) * 1024 + col, v[rr][j]);
      }
    }
    float v32[32];
#pragma unroll
    for (int e = 0; e < 16; ++e) {
      float a0 = 0.f, a1 = 0.f;
#pragma unroll
      for (int j = 0; j < 4; ++j) {
        const f32x4 w = *(const f32x4*)(wl + e * 1024 + j * 256 + lane * 4);
        a0 += v[0][j][0] * w[0] + v[0][j][1] * w[1] + v[0][j][2] * w[2] + v[0][j][3] * w[3];
        a1 += v[1][j][0] * w[0] + v[1][j][1] * w[1] + v[1][j][2] * w[2] + v[1][j][3] * w[3];
      }
      v32[e] = a0; v32[16 + e] = a1;
      if (e & 1) __builtin_amdgcn_sched_barrier(0);
    }
    const bool b5 = (lane & 32) != 0, b4 = (lane & 16) != 0, b3 = (lane & 8) != 0, b2 = (lane & 4) != 0, b1 = (lane & 2) != 0;
    float w16[16];
#pragma unroll
    for (int i = 0; i < 16; ++i) { const float keep = b5 ? v32[i + 16] : v32[i], send = b5 ? v32[i] : v32[i + 16]; w16[i] = keep + __shfl_xor(send, 32); }
    float w8[8];
#pragma unroll
    for (int i = 0; i < 8; ++i) { const float keep = b4 ? w16[i + 8] : w16[i], send = b4 ? w16[i] : w16[i + 8]; w8[i] = keep + __shfl_xor(send, 16); }
    float w4[4];
#pragma unroll
    for (int i = 0; i < 4; ++i) { const float keep = b3 ? w8[i + 4] : w8[i], send = b3 ? w8[i] : w8[i + 4]; w4[i] = keep + __shfl_xor(send, 8); }
    float w2[2];
#pragma unroll
    for (int i = 0; i < 2; ++i) { const float keep = b2 ? w4[i + 2] : w4[i], send = b2 ? w4[i] : w4[i + 2]; w2[i] = keep + __shfl_xor(send, 4); }
    float z = (b1 ? w2[1] : w2[0]) + __shfl_xor(b1 ? w2[0] : w2[1], 2);
    z += __shfl_xor(z, 1);
    float mx = z;
    mx = fmaxf(mx, __shfl_xor(mx, 2)); mx = fmaxf(mx, __shfl_xor(mx, 4)); mx = fmaxf(mx, __shfl_xor(mx, 8)); mx = fmaxf(mx, __shfl_xor(mx, 16));
    const float ex = __expf(z - mx);
    float sum = ex;
    sum += __shfl_xor(sum, 2); sum += __shfl_xor(sum, 4); sum += __shfl_xor(sum, 8); sum += __shfl_xor(sum, 16);
    if ((lane & 1) == 0) {
      const int rr = lane >> 5, e = (lane >> 1) & 15, n = (row0 + rr) & 4095;
      P.aff[((size_t)b * 16 + e) * 4096 + n] = ex / sum;
    }
  }
}

__device__ void topk_unit(const Params& P, char* lds, int be) {
  const int tid = otid(), lane = tid & 63, wave = tid >> 6;
  unsigned* keys = (unsigned*)lds;
  unsigned* wsum = (unsigned*)(lds + 16384);
  const float* a = P.aff + (size_t)be * 4096;
  unsigned kv[8];
#pragma unroll
  for (int i = 0; i < 8; ++i) { kv[i] = __float_as_uint(a[tid * 8 + i]); keys[tid * 8 + i] = kv[i]; }
  unsigned prefix = 0;
  for (int bit = 31; bit >= 0; --bit) {
    const unsigned cand = prefix | (1u << bit);
    unsigned cnt = 0;
#pragma unroll
    for (int i = 0; i < 8; ++i) cnt += (kv[i] >= cand) ? 1u : 0u;
#pragma unroll
    for (int o = 32; o > 0; o >>= 1) cnt += __shfl_xor(cnt, o);
    __syncthreads();
    if (lane == 0) wsum[wave] = cnt;
    __syncthreads();
    unsigned tot = 0;
#pragma unroll
    for (int w = 0; w < 8; ++w) tot += wsum[w];
    if (tot >= 512u) prefix = cand;
  }
  unsigned gt = 0, eq = 0;
#pragma unroll
  for (int i = 0; i < 8; ++i) { gt += (kv[i] > prefix) ? 1u : 0u; eq += (kv[i] == prefix) ? 1u : 0u; }
  unsigned packed = gt | (eq << 16);
  unsigned incl = packed;
#pragma unroll
  for (int o = 1; o < 64; o <<= 1) { const unsigned t = __shfl_up(incl, o); if (lane >= o) incl += t; }
  __syncthreads();
  if (lane == 63) wsum[wave] = incl;
  __syncthreads();
  unsigned base = 0, total = 0;
#pragma unroll
  for (int w = 0; w < 8; ++w) { const unsigned s = wsum[w]; if (w < wave) base += s; total += s; }
  const unsigned excl = base + incl - packed;
  unsigned gpos = excl & 0xffffu, epos = excl >> 16;
  const unsigned ngt = total & 0xffffu;
  const unsigned need = 512u - ngt;
#pragma unroll
  for (int i = 0; i < 8; ++i) {
    const int n = tid * 8 + i;
    int slot = -1;
    if (kv[i] > prefix) { slot = (int)gpos; ++gpos; }
    else if (kv[i] == prefix) { if (epos < need) slot = (int)(ngt + epos); ++epos; }
    if (slot >= 0) { P.idx[be * 512 + slot] = n; P.gate[be * 512 + slot] = __uint_as_float(kv[i]); }
    P.inv[((size_t)(be >> 4) * 4096 + n) * 16 + (be & 15)] = slot;
  }
}

__device__ void phase_conv(const Params& P) {
  const size_t nitems = (size_t)2048 * 128;
  for (size_t it = (size_t)blockIdx.x * NTHREADS + threadIdx.x; it < nitems; it += (size_t)gridDim.x * NTHREADS) {
    const int tb = (int)(it >> 7), c0 = (int)(it & 127) * 8, t0 = tb * 8, n0 = t0 & 4095;
    u32x4 z[10], bg[8];
    z[0] = (u32x4){0, 0, 0, 0}; z[9] = (u32x4){0, 0, 0, 0};
    if (n0 > 0) z[0] = *(const u32x4*)(P.Zc + (size_t)(t0 - 1) * 1024 + c0);
#pragma unroll
    for (int r = 0; r < 8; ++r) { z[r + 1] = *(const u32x4*)(P.Zc + (size_t)(t0 + r) * 1024 + c0); bg[r] = *(const u32x4*)(P.BG + (size_t)(t0 + r) * 1024 + c0); }
    if (n0 + 8 < 4096) z[9] = *(const u32x4*)(P.Zc + (size_t)(t0 + 8) * 1024 + c0);
    float w0[8], w1[8], w2[8];
#pragma unroll
    for (int q = 0; q < 2; ++q) {
      const f32x4 a = *(const f32x4*)(P.conv_w + c0 + q * 4), b = *(const f32x4*)(P.conv_w + 1024 + c0 + q * 4), c = *(const f32x4*)(P.conv_w + 2048 + c0 + q * 4);
#pragma unroll
      for (int i = 0; i < 4; ++i) { w0[q * 4 + i] = a[i]; w1[q * 4 + i] = b[i]; w2[q * 4 + i] = c[i]; }
    }
#pragma unroll
    for (int r = 0; r < 8; ++r) {
      u32x4 o;
#pragma unroll
      for (int i = 0; i < 4; ++i) {
        const float lo = bf2f((unsigned short)(bg[r][i] & 0xffff)) * (w0[2 * i] * bf2f((unsigned short)(z[r][i] & 0xffff)) + w1[2 * i] * bf2f((unsigned short)(z[r + 1][i] & 0xffff)) + w2[2 * i] * bf2f((unsigned short)(z[r + 2][i] & 0xffff)));
        const float hi = bf2f((unsigned short)(bg[r][i] >> 16)) * (w0[2 * i + 1] * bf2f((unsigned short)(z[r][i] >> 16)) + w1[2 * i + 1] * bf2f((unsigned short)(z[r + 1][i] >> 16)) + w2[2 * i + 1] * bf2f((unsigned short)(z[r + 2][i] >> 16)));
        o[i] = pk_bf16(lo, hi);
      }
      *(u32x4*)(P.OCAT + (size_t)(t0 + r) * 1024 + c0) = o;
    }
  }
}

#define GEMM_PRE() const int tid = otid(), lane = tid & 63, wave = tid >> 6, wm = wave >> 2, wn = wave & 3, l15 = lane & 15, quad = lane >> 4, lr = tid >> 3, lc = ((tid & 7) ^ ((tid >> 4) & 7)) * 8;     \
  f32x4 acc[4][4]; (void)lane; (void)wm; (void)wn; (void)l15; (void)quad;

__device__ void inproj_unit(const Params& P, char* lds, int u) {
  GEMM_PRE();
  if (u < 768) {
    const int mt = u / 6, nt = u % 6;
    gemm_mainloop(lds, P.H + (size_t)(mt * 128 + lr) * 1024 + lc, P.H + (size_t)(mt * 128 + 64 + lr) * 1024 + lc, P.wt_in0 + (size_t)(nt * 256 + lr) * 1024 + lc, 1024, 1024, acc);
    const int nb = nt * 256 + wn * 64;
    const bool isq = nb < 768;
    const float* gn = isq ? P.q_norm : P.k_norm;
    f32x4 gv[4];
#pragma unroll
    for (int n = 0; n < 4; ++n) gv[n] = *(const f32x4*)(gn + n * 16 + quad * 4);
#pragma unroll
    for (int m = 0; m < 4; ++m) {
      const int t = mt * 128 + wm * 64 + m * 16 + l15, b = t >> 12, np = t & 4095, pr = np >> 6, pc = np & 63;
      float ss = 0.f;
#pragma unroll
      for (int n = 0; n < 4; ++n) ss += acc[m][n][0] * acc[m][n][0] + acc[m][n][1] * acc[m][n][1] + acc[m][n][2] * acc[m][n][2] + acc[m][n][3] * acc[m][n][3];
      ss += __shfl_xor(ss, 16); ss += __shfl_xor(ss, 32);
      const float rinv = rsqrtf(ss * (1.f / 64.f) + EPSV);
      const f32x4 cr = *(const f32x4*)(P.rope + pr * 16 + quad * 4), sr = *(const f32x4*)(P.rope + 1024 + pr * 16 + quad * 4);
      const f32x4 cc = *(const f32x4*)(P.rope + pc * 16 + quad * 4), sc = *(const f32x4*)(P.rope + 1024 + pc * 16 + quad * 4);
      f32x4 x0 = acc[m][0] * rinv * gv[0], x1 = acc[m][1] * rinv * gv[1], x2 = acc[m][2] * rinv * gv[2], x3 = acc[m][3] * rinv * gv[3];
      f32x4 y0 = x0 * cr - x1 * sr, y1 = x1 * cr + x0 * sr, y2 = x2 * cc - x3 * sc, y3 = x3 * cc + x2 * sc;
      bf16_t* dp;
      if (isq) { const float qs = 0.125f * 1.44269504f; y0 *= qs; y1 *= qs; y2 *= qs; y3 *= qs; dp = P.Q + (size_t)t * 768 + nb + quad * 4; }
      else dp = P.Kb + ((size_t)b * 4352 + np) * 768 + (nb - 768) + quad * 4;
      store4_bf16(dp, y0); store4_bf16(dp + 16, y1); store4_bf16(dp + 32, y2); store4_bf16(dp + 48, y3);
    }
  } else if (u < 1152) {
    const int id = u - 768, mt = id >> 6, nt = id & 63;
    gemm_mainloop(lds, P.wt_in0 + (size_t)(1536 + mt * 128 + lr) * 1024 + lc, P.wt_in0 + (size_t)(1536 + mt * 128 + 64 + lr) * 1024 + lc, P.H + (size_t)(nt * 256 + lr) * 1024 + lc, 1024, 1024, acc);
#pragma unroll
    for (int m = 0; m < 4; ++m) {
      const int c = mt * 128 + wm * 64 + m * 16 + l15;
#pragma unroll
      for (int n = 0; n < 4; ++n) {
        const int t = nt * 256 + wn * 64 + n * 16 + quad * 4, b = t >> 12, np = t & 4095;
        store4_bf16(P.Vt + ((size_t)b * 768 + c) * 4352 + (np & ~31) + quad * 8 + (n & 1) * 4, acc[m][n]);
      }
    }
  } else if (u < 1408) {
    const int id = u - 1152, mt = id >> 6, nt = id & 63;
    gemm_mainloop(lds, P.wt_in0 + (size_t)(2304 + mt * 128 + lr) * 1024 + lc, P.wt_in0 + (size_t)(2304 + mt * 128 + 64 + lr) * 1024 + lc, P.H + (size_t)(nt * 256 + lr) * 1024 + lc, 1024, 1024, acc);
#pragma unroll
    for (int m = 0; m < 4; ++m) {
      const int jj = mt * 128 + wm * 64 + m * 16 + l15, which = jj >> 8, cp = jj & 255;
#pragma unroll
      for (int n = 0; n < 4; ++n) {
        const int t = nt * 256 + wn * 64 + n * 16 + quad * 4, b = t >> 12, np = t & 4095;
        store4_bf16(P.Zt + ((size_t)b * 256 + cp) * 8192 + which * 4096 + np, acc[m][n]);
      }
    }
  } else if (u < 1432) {
    const int id = u - 1408, mt = id / 3, nt = id % 3;
    gemm_mainloop(lds, P.HC + (size_t)(mt * 128 + lr) * 1024 + lc, P.HC + (size_t)(mt * 128 + 64 + lr) * 1024 + lc, P.wt_in0 + (size_t)(768 + nt * 256 + lr) * 1024 + lc, 1024, 1024, acc);
    const int nb = nt * 256 + wn * 64;
    f32x4 gv[4];
#pragma unroll
    for (int n = 0; n < 4; ++n) gv[n] = *(const f32x4*)(P.k_norm + n * 16 + quad * 4);
#pragma unroll
    for (int m = 0; m < 4; ++m) {
      const int rr = mt * 128 + wm * 64 + m * 16 + l15, b = rr >> 8, j = rr & 255;
      float ss = 0.f;
#pragma unroll
      for (int n = 0; n < 4; ++n) ss += acc[m][n][0] * acc[m][n][0] + acc[m][n][1] * acc[m][n][1] + acc[m][n][2] * acc[m][n][2] + acc[m][n][3] * acc[m][n][3];
      ss += __shfl_xor(ss, 16); ss += __shfl_xor(ss, 32);
      const float rinv = rsqrtf(ss * (1.f / 64.f) + EPSV);
      bf16_t* dp = P.Kb + ((size_t)b * 4352 + 4096 + j) * 768 + nb + quad * 4;
#pragma unroll
      for (int n = 0; n < 4; ++n) store4_bf16(dp + n * 16, acc[m][n] * rinv * gv[n]);
    }
  } else {
    const int id = u - 1432, mt = id >> 2, nt = id & 3;
    gemm_mainloop(lds, P.wt_in0 + (size_t)(1536 + mt * 128 + lr) * 1024 + lc, P.wt_in0 + (size_t)(1536 + mt * 128 + 64 + lr) * 1024 + lc, P.HC + (size_t)(nt * 256 + lr) * 1024 + lc, 1024, 1024, acc);
#pragma unroll
    for (int m = 0; m < 4; ++m) {
      const int c = mt * 128 + wm * 64 + m * 16 + l15;
#pragma unroll
      for (int n = 0; n < 4; ++n) {
        const int rr = nt * 256 + wn * 64 + n * 16 + quad * 4, b = rr >> 8, j = rr & 255;
        store4_bf16(P.Vt + ((size_t)b * 768 + c) * 4352 + 4096 + (j & ~31) + quad * 8 + (n & 1) * 4, acc[m][n]);
      }
    }
  }
}

__device__ void dft_unit(const Params& P, char* lds, int id) {
  GEMM_PRE();
  const int b = id >> 4, mt = id & 15;
  const bf16_t* Bt = P.Zt + (size_t)b * 256 * 8192;
  gemm_mainloop(lds, P.dft + (size_t)(mt * 128 + lr) * 8192 + lc, P.dft + (size_t)(mt * 128 + 64 + lr) * 8192 + lc, Bt + (size_t)lr * 8192 + lc, 8192, 4096, acc);
  float* park = (float*)P.A2 + (size_t)id * 32768 + (size_t)tid * 4;
#pragma unroll
  for (int m = 0; m < 4; ++m)
#pragma unroll
    for (int n = 0; n < 4; ++n) *(f32x4*)(park + (m * 4 + n) * 2048) = acc[m][n];
  gemm_mainloop(lds, P.dft + (size_t)(mt * 128 + lr) * 8192 + 4096 + lc, P.dft + (size_t)(mt * 128 + 64 + lr) * 8192 + 4096 + lc, Bt + (size_t)lr * 8192 + 4096 + lc, 8192, 4096, acc);
#pragma unroll
  for (int m = 0; m < 4; ++m) {
    const int k = mt * 128 + wm * 64 + m * 16 + l15;
#pragma unroll
    for (int n = 0; n < 4; ++n) {
      const int col = 768 + wn * 64 + n * 16 + quad * 4;
      const f32x4 uu = *(const f32x4*)(park + (m * 4 + n) * 2048);
      store4_bf16(P.OCAT + ((size_t)b * 4096 + k) * 1024 + col, (uu + acc[m][n]) * (1.f / 512.f));
      if (k > 0) store4_bf16(P.OCAT + ((size_t)b * 4096 + (4096 - k)) * 1024 + col, (uu - acc[m][n]) * (1.f / 512.f));
    }
  }
}
__device__ void dft_nyquist_unit(const Params& P, int b) {
  const int tid = otid();
  const int cp = tid >> 1, half = tid & 1;
  const bf16_t* src = P.Zt + ((size_t)b * 256 + cp) * 8192 + half * 2048;
  float se = 0.f, so = 0.f;
#pragma unroll 8
  for (int i = 0; i < 256; ++i) {
    const u32x4 w = *(const u32x4*)(src + i * 8);
#pragma unroll
    for (int j = 0; j < 4; ++j) { se += __uint_as_float(w[j] << 16); so += __uint_as_float(w[j] & 0xffff0000u); }
  }
  float v = se - so;
  v += __shfl_xor(v, 1);
  if (half == 0) P.OCAT[((size_t)b * 4096 + 2048) * 1024 + 768 + cp] = (bf16_t)(pk_bf16(v * (1.f / 512.f), 0.f) & 0xffffu);
}

__device__ void outproj_unit(const Params& P, char* lds, int u, const bf16_t* Wt, const float* xin, int l) {
  GEMM_PRE();
  const int mt = u >> 2, nt = u & 3;
  gemm_mainloop(lds, P.OCAT + (size_t)(mt * 128 + lr) * 1024 + lc, P.OCAT + (size_t)(mt * 128 + 64 + lr) * 1024 + lc, Wt + (size_t)(nt * 256 + lr) * 1024 + lc, 1024, 1024, acc);
#pragma unroll
  for (int m = 0; m < 4; ++m) {
    const int t = mt * 128 + wm * 64 + m * 16 + l15, b = t >> 12;
#pragma unroll
    for (int n = 0; n < 4; ++n) {
      const int c = nt * 256 + wn * 64 + n * 16 + quad * 4;
      const f32x4 g = *(const f32x4*)(P.mods + ((size_t)l * 5 + b) * 6144 + 2048 + c);
      const f32x4 xv = xin ? *(const f32x4*)(xin + (size_t)t * 1024 + c) : load4_bf16(P.XB + (size_t)t * 1024 + c);
      store4_bf16(P.XB + (size_t)t * 1024 + c, xv + g * acc[m][n]);
    }
  }
}

__device__ __forceinline__ float silu_f(float v) { return v / (1.f + __expf(-v)); }

__device__ void moe_gu_unit(const Params& P, char* lds, int u, int l) {
  GEMM_PRE();
  const int mt = u & 3, b = (u >> 2) & 3, nt = (u >> 4) & 7, e = u >> 7, be = b * 16 + e;
  const int tok = P.idx[be * 512 + mt * 128 + lr], tok1 = P.idx[be * 512 + mt * 128 + 64 + lr];
  const bf16_t* Wt = P.wt_gu + ((size_t)(l * 16 + e) * 2048 + nt * 256) * 1024;
  gemm_mainloop(lds, P.H + ((size_t)b * 4096 + tok) * 1024 + lc, P.H + ((size_t)b * 4096 + tok1) * 1024 + lc, Wt + (size_t)lr * 1024 + lc, 1024, 1024, acc);
#pragma unroll
  for (int m = 0; m < 4; ++m) {
    const int rl = mt * 128 + wm * 64 + m * 16 + l15;
    bf16_t* dp = P.A2 + ((size_t)be * 512 + rl) * 1024 + nt * 128 + wn * 32 + quad * 4;
#pragma unroll
    for (int pp = 0; pp < 2; ++pp) {
      f32x4 a;
#pragma unroll
      for (int r = 0; r < 4; ++r) a[r] = silu_f(acc[m][2 * pp][r]) * acc[m][2 * pp + 1][r];
      store4_bf16(dp + pp * 16, a);
    }
  }
}

__device__ void moe_down_unit(const Params& P, char* lds, int u, int l) {
  GEMM_PRE();
  const int mt = u & 3, b = (u >> 2) & 3, nt = (u >> 4) & 3, e = u >> 6, be = b * 16 + e;
  const bf16_t* Wt = P.wt_d + ((size_t)(l * 16 + e) * 1024 + nt * 256) * 1024;
  gemm_mainloop(lds, P.A2 + ((size_t)be * 512 + mt * 128 + lr) * 1024 + lc, P.A2 + ((size_t)be * 512 + mt * 128 + 64 + lr) * 1024 + lc, Wt + (size_t)lr * 1024 + lc, 1024, 1024, acc);
#pragma unroll
  for (int m = 0; m < 4; ++m) {
    const int rl = mt * 128 + wm * 64 + m * 16 + l15;
    unsigned char* yp = (unsigned char*)P.Y + ((size_t)be * 512 + rl) * 1024 + nt * 256 + wn * 64 + quad * 4;
#pragma unroll
    for (int n = 0; n < 4; ++n) {
      int pk_ = 0;
      pk_ = __builtin_amdgcn_cvt_pk_fp8_f32(acc[m][n][0], acc[m][n][1], pk_, false);
      pk_ = __builtin_amdgcn_cvt_pk_fp8_f32(acc[m][n][2], acc[m][n][3], pk_, true);
      *(unsigned*)(yp + n * 16) = (unsigned)pk_;
    }
  }
}

__device__ void convin_unit(const Params& P, char* lds, int u) {
  GEMM_PRE();
  const int mt = u / 12, nt = u % 12;
  const bf16_t* Wt = P.wt_cin + (size_t)nt * 256 * 1024;
  gemm_mainloop(lds, P.H + (size_t)(mt * 128 + lr) * 1024 + lc, P.H + (size_t)(mt * 128 + 64 + lr) * 1024 + lc, Wt + (size_t)lr * 1024 + lc, 1024, 1024, acc);
#pragma unroll
  for (int m = 0; m < 4; ++m) {
    const int t = mt * 128 + wm * 64 + m * 16 + l15;
    if (nt < 8) {
      bf16_t* dp = P.Zc + (size_t)t * 1024 + nt * 128 + wn * 32 + quad * 4;
      store4_bf16(dp, acc[m][0] * acc[m][1]);
      store4_bf16(dp + 16, acc[m][2] * acc[m][3]);
    } else {
      bf16_t* dp = P.BG + (size_t)t * 1024 + (nt - 8) * 256 + wn * 64 + quad * 4;
#pragma unroll
      for (int n = 0; n < 4; ++n) store4_bf16(dp + n * 16, acc[m][n]);
    }
  }
}

__device__ void attn_unit(const Params& P, char* lds, int u) {
  const int tid = otid(), lane = tid & 63, wave = tid >> 6, l15 = lane & 15, quad = lane >> 4;
  const int qg = wave & 3, sm = wave >> 2;
  const int qblk = u & 31, h = (u >> 5) % 6, b = u / 192;
  const int q0 = qblk * 128 + qg * 32;
  float lam;
  {
    const float a = wave_sum(P.lam_q1[lane] * P.lam_k1[lane]), c = wave_sum(P.lam_q2[lane] * P.lam_k2[lane]);
    lam = __expf(a) - __expf(c) + 0.2f;
  }
  float negM;
  {
    float gq = fabsf(P.q_norm[lane]), gk = fabsf(P.k_norm[lane]);
#pragma unroll
    for (int o_ = 32; o_ > 0; o_ >>= 1) { gq = fmaxf(gq, __shfl_xor(gq, o_)); gk = fmaxf(gk, __shfl_xor(gk, o_)); }
    negM = -(gq * gk * (8.f * 1.44269504f) * 1.02f + 0.5f);
  }
  bf16x8 qf[2][2];
#pragma unroll
  for (int qb = 0; qb < 2; ++qb)
#pragma unroll
    for (int ds = 0; ds < 2; ++ds)
      qf[qb][ds] = *(const bf16x8*)(P.Q + (size_t)(b * 4096 + q0 + qb * 16 + l15) * 768 + h * 128 + sm * 64 + ds * 32 + quad * 8);
  f32x4 o[8][2];
#pragma unroll
  for (int eb = 0; eb < 8; ++eb) { o[eb][0] = (f32x4){0.f, 0.f, 0.f, 0.f}; o[eb][1] = (f32x4){0.f, 0.f, 0.f, 0.f}; }
  f32x4 lsum[2] = {(f32x4){0.f, 0.f, 0.f, 0.f}, (f32x4){0.f, 0.f, 0.f, 0.f}};
  const bf16x8 ones8 = {(short)0x3F80, (short)0x3F80, (short)0x3F80, (short)0x3F80, (short)0x3F80, (short)0x3F80, (short)0x3F80, (short)0x3F80};
  const int kkey = tid >> 3, gch = (tid & 7) ^ ((tid >> 4) & 7);
  const bf16_t* kp0 = P.Kb + ((size_t)b * 4352 + kkey) * 768 + h * 128 + gch * 8;
  const bf16_t* vp0 = P.Vt + ((size_t)b * 768 + h * 128 + kkey) * 4352 + gch * 8;
  const bf16_t* vp1 = vp0 + (size_t)64 * 4352;
  char* lw = lds + __builtin_amdgcn_readfirstlane(wave) * 1024;
  glds16(kp0, lw); glds16(kp0 + 64, lw + 8192); glds16(vp0, lw + 16384); glds16(vp1, lw + 24576);
  __syncthreads();
  const int NT = 68;
  int koff[2], voff[2][2];
#pragma unroll
  for (int ds = 0; ds < 2; ++ds) koff[ds] = l15 * 128 + (((ds * 4 + quad) ^ ((l15 >> 1) & 7)) * 16);
#pragma unroll
  for (int ks = 0; ks < 2; ++ks) {
    const int c0 = ks * 4 + (quad >> 1), c1 = c0 + 2, wi = (quad & 1) * 8;
    voff[ks][0] = l15 * 128 + ((c0 ^ (l15 & 7)) * 16) + wi;
    voff[ks][1] = l15 * 128 + ((c1 ^ (l15 & 7)) * 16) + wi;
  }
  for (int kt = 0; kt < NT; ++kt) {
    const int cur = kt & 1;
    const bool more = kt + 1 < NT;
    if (more) {
      const size_t ko = (size_t)(kt + 1) * 64 * 768;
      char* nb = lw + (cur ^ 1) * 32768;
      glds16(kp0 + ko, nb); glds16(kp0 + ko + 64, nb + 8192); glds16(vp0 + (kt + 1) * 64, nb + 16384); glds16(vp1 + (kt + 1) * 64, nb + 24576);
    }
    const char* Ks = lds + cur * 32768 + sm * 8192;
    const char* Vs = lds + cur * 32768 + 16384;
    f32x4 s[4][2];
#pragma unroll
    for (int kb = 0; kb < 4; ++kb) { s[kb][0] = (f32x4){negM, negM, negM, negM}; s[kb][1] = (f32x4){negM, negM, negM, negM}; }
#pragma unroll
    for (int kb = 0; kb < 4; ++kb)
#pragma unroll
      for (int ds = 0; ds < 2; ++ds) {
        const bf16x8 kf = *(const bf16x8*)(Ks + koff[ds] + kb * 2048);
        s[kb][0] = mfma16(kf, qf[0][ds], s[kb][0]);
        s[kb][1] = mfma16(kf, qf[1][ds], s[kb][1]);
      }
    bf16x8 pf[2][2];
    __builtin_amdgcn_sched_barrier(0);
#pragma unroll
    for (int qb = 0; qb < 2; ++qb) {
#pragma unroll
      for (int kb = 0; kb < 4; ++kb)
#pragma unroll
        for (int r = 0; r < 4; ++r) s[kb][qb][r] = __builtin_amdgcn_exp2f(s[kb][qb][r]);
#pragma unroll
      for (int ks = 0; ks < 2; ++ks) {
        u32x4 w;
        w.x = pk_bf16(s[2 * ks][qb][0], s[2 * ks][qb][1]); w.y = pk_bf16(s[2 * ks][qb][2], s[2 * ks][qb][3]);
        w.z = pk_bf16(s[2 * ks + 1][qb][0], s[2 * ks + 1][qb][1]); w.w = pk_bf16(s[2 * ks + 1][qb][2], s[2 * ks + 1][qb][3]);
        pf[qb][ks] = __builtin_bit_cast(bf16x8, w);
      }
    }
    __builtin_amdgcn_sched_barrier(0);
#pragma unroll
    for (int ks = 0; ks < 2; ++ks) { lsum[0] = mfma16(ones8, pf[0][ks], lsum[0]); lsum[1] = mfma16(ones8, pf[1][ks], lsum[1]); }
#pragma unroll
    for (int eb = 0; eb < 8; ++eb)
#pragma unroll
      for (int ks = 0; ks < 2; ++ks) {
        const bf16x8 vf = *(const bf16x8*)(Vs + koff[ks] + eb * 2048);
        o[eb][0] = mfma16(vf, pf[0][ks], o[eb][0]);
        o[eb][1] = mfma16(vf, pf[1][ks], o[eb][1]);
        if (ks == 1 && (eb & 1)) __builtin_amdgcn_sched_barrier(0);
      }
    __builtin_amdgcn_sched_barrier(0);
    __syncthreads();
  }
#pragma unroll
  for (int qb = 0; qb < 2; ++qb) {
    const float inv = 1.f / lsum[qb][0];
#pragma unroll
    for (int eb = 0; eb < 8; ++eb) o[eb][qb] *= inv;
  }
  float* comb = (float*)lds;
  if (sm == 1) {
#pragma unroll
    for (int eb = 0; eb < 8; ++eb)
#pragma unroll
      for (int qb = 0; qb < 2; ++qb)
#pragma unroll
        for (int r = 0; r < 4; ++r) comb[(qg * 64 + eb * 8 + qb * 4 + r) * 64 + lane] = o[eb][qb][r];
  }
  __syncthreads();
  if (sm == 0) {
#pragma unroll
    for (int qb = 0; qb < 2; ++qb) {
      float ss = 0.f;
#pragma unroll
      for (int eb = 0; eb < 8; ++eb)
#pragma unroll
        for (int r = 0; r < 4; ++r) { const float v = o[eb][qb][r] - lam * comb[(qg * 64 + eb * 8 + qb * 4 + r) * 64 + lane]; o[eb][qb][r] = v; ss += v * v; }
      ss += __shfl_xor(ss, 16); ss += __shfl_xor(ss, 32);
      const float rinv = rsqrtf(ss * (1.f / 128.f) + EPSV) * 0.8f;
      bf16_t* dp = P.OCAT + (size_t)(b * 4096 + q0 + qb * 16 + l15) * 1024 + h * 128 + quad * 4;
#pragma unroll
      for (int eb = 0; eb < 8; ++eb) {
        const f32x4 g = *(const f32x4*)(P.subln + eb * 16 + quad * 4);
        store4_bf16(dp + eb * 16, o[eb][qb] * rinv * g);
      }
    }
  }
}


#define XB_TMO      128
#define XB_XCNT(j)  (256  + 64 * (j))
#define XB_XSUB(j)  (1280 + 64 * (j))
#define XB_XGEN(j)  (2304 + 64 * (j))
#define XB_TOP      3328
#define XB_TOPGEN   3392
#define XCD_BAR_WORDS 3456
#define XB_SPIN_CAP (1u << 18)
#define LAS __attribute__((address_space(3)))
__device__ __forceinline__ unsigned xb_ld(unsigned* p)              { return __hip_atomic_load(p, __ATOMIC_RELAXED, __HIP_MEMORY_SCOPE_AGENT); }
__device__ __forceinline__ unsigned xb_add(unsigned* p, unsigned v) { return __hip_atomic_fetch_add(p, v, __ATOMIC_RELAXED, __HIP_MEMORY_SCOPE_AGENT); }
__device__ __forceinline__ unsigned xb_xcc_id() { return (unsigned)__builtin_amdgcn_s_getreg((3 << 11) | 20) & 0xFu; }
#define XB_SPIN(cond, bar) do { unsigned _sp = 0; while (cond) { __builtin_amdgcn_s_sleep(1); \
    if ((++_sp & 255u) == 0u) { if (xb_ld(&(bar)[XB_TMO])) break; if (_sp > XB_SPIN_CAP) { atomicAdd(&(bar)[XB_TMO], 1u); break; } } } } while (0)
struct XcdBarrier { unsigned* bar; unsigned x; volatile LAS unsigned* st; };
__device__ __forceinline__ XcdBarrier xcd_barrier_post(unsigned* bar, volatile LAS unsigned* st) {
    XcdBarrier b; b.bar = bar; b.x = xb_xcc_id(); b.st = st;
    if (threadIdx.x == 0) (void)xb_add(&bar[XB_XCNT(b.x)], 1u);
    return b;
}
__device__ __forceinline__ void xcd_barrier_complete(unsigned* bar, unsigned x, unsigned& nloc, unsigned& nx) {
    const unsigned G = gridDim.x * gridDim.y * gridDim.z;
    unsigned sum, cnt, mine, sp = 0u;
    for (;;) {
        sum = 0u; cnt = 0u; mine = 0u;
#pragma unroll
        for (unsigned j = 0; j < 16; ++j) { const unsigned c = xb_ld(&bar[XB_XCNT(j)]); sum += c; cnt += (c > 0u) ? 1u : 0u; mine = (j == x) ? c : mine; }
        if (sum == G) break;
        __builtin_amdgcn_s_sleep(1);
        if ((++sp & 255u) == 0u) { if (xb_ld(&bar[XB_TMO])) break; if (sp > XB_SPIN_CAP) { atomicAdd(&bar[XB_TMO], 1u); break; } }
    }
    nloc = mine > 0u ? mine : 1u; nx = cnt > 0u ? cnt : 1u;
}
__device__ __forceinline__ void xcd_barrier(const XcdBarrier& b) {
    asm volatile("s_waitcnt vmcnt(0)" ::: "memory");
    __syncthreads();
    if (threadIdx.x == 0) {
        unsigned* bar = b.bar;
        __builtin_amdgcn_s_waitcnt(0);
        unsigned nloc = b.st[0], nx = b.st[1];
        if (nloc == 0u) { xcd_barrier_complete(bar, b.x, nloc, nx); b.st[0] = nloc; b.st[1] = nx; }
        const unsigned old = xb_add(&bar[XB_XSUB(b.x)], 1u);
        const unsigned gen = old / nloc;
        if (old + 1u == (gen + 1u) * nloc) {
            __builtin_amdgcn_fence(__ATOMIC_RELEASE, "agent");
            asm volatile("s_waitcnt vmcnt(0)" ::: "memory");
            const unsigned og = xb_add(&bar[XB_TOP], 1u);
            const unsigned tg = og / nx;
            if (og + 1u == (tg + 1u) * nx) xb_add(&bar[XB_TOPGEN], 1u);
            else XB_SPIN(xb_ld(&bar[XB_TOPGEN]) == tg, bar);
            __builtin_amdgcn_fence(__ATOMIC_ACQUIRE, "agent");
            xb_add(&bar[XB_XGEN(b.x)], 1u);
            asm volatile("s_waitcnt vmcnt(0)" ::: "memory");
        } else {
            XB_SPIN(xb_ld(&bar[XB_XGEN(b.x)]) == gen, bar);
            __builtin_amdgcn_fence(__ATOMIC_ACQUIRE, "agent");
            asm volatile("s_waitcnt vmcnt(0)" ::: "memory");
        }
    }
    __syncthreads();
}

__global__ void __launch_bounds__(NTHREADS) fwd_megakernel(Params P) {
  extern __shared__ __attribute__((aligned(16))) char lds[];
  int* s_unit_p = (int*)(lds + LDS_BYTES);
  int u;
  volatile LAS unsigned* xst = (volatile LAS unsigned*)(lds + LDS_BYTES + 16);
  if (threadIdx.x == 0) { xst[0] = 0u; xst[1] = 0u; }
  __syncthreads();
  const XcdBarrier xb = xcd_barrier_post(P.counters, xst);
#define PHASE_BEGIN(k) if (P.phase_lo <= (k) && (k) < P.phase_hi) { if ((k) > P.phase_lo) xcd_barrier(xb); unsigned* ctr = P.counters + (k); (void)ctr;
#define PHASE_END }
  const int ubase = (int)((blockIdx.x & 7u) * (gridDim.x >> 3) + (blockIdx.x >> 3));
#define FOR_UNITS(N) for (u = ubase; u < (N); u += gridDim.x)
#define USYNC __syncthreads();
  PHASE_BEGIN(0)
    FOR_UNITS(P0_GEMV + P0_DFT + P0_FOLD + P0_ROPE) {
      USYNC
      if (u < P0_GEMV) p0_gemv(P, lds, u);
      else if (u < P0_GEMV + P0_DFT) p0_dft(P, lds, u - P0_GEMV);
      else if (u < P0_GEMV + P0_DFT + P0_FOLD) p0_fold(P, lds, u - P0_GEMV - P0_DFT);
      else p0_rope(P);
    }
    USYNC
    cvt_stream(P, lds, u - (P0_GEMV + P0_DFT + P0_FOLD + P0_ROPE), (int)gridDim.x, P0_CVT);
  PHASE_END
  PHASE_BEGIN(1) for (int rep = 0; rep < DBG_REPS; ++rep) phase_modulate(P, P.x, 0, true, -1); PHASE_END
  PHASE_BEGIN(2)
    int q_;
    while ((q_ = next_unit(ctr, s_unit_p)) < 762 * 3 + 6) {
      if (q_ >= 762 * 3 || (q_ % 3) == 2) {
        const int cg_ = (q_ >= 762 * 3) ? (762 + (q_ - 762 * 3)) : (q_ / 3);
        cvt_stream(P, lds, CVT_SMALL + cg_ * 4, 1, CVT_SMALL + cg_ * 4 + 4);
        continue;
      }
      u = (q_ / 3) * 2 + (q_ % 3);
      if (u >= 256 && u < 324) {
        const int bb = (u < 260) ? (u - 256) : ((u - 260) >> 4);
        if (threadIdx.x == 0) {
          unsigned sp_ = 0;
          while (xb_ld(&P.counters[32 + bb]) < 64u) { __builtin_amdgcn_s_sleep(2); if (++sp_ > (1u << 22)) break; }
          __builtin_amdgcn_fence(__ATOMIC_ACQUIRE, "agent");
          asm volatile("s_waitcnt vmcnt(0)" ::: "memory");
        }
        __syncthreads();
        if (u < 260) dft_nyquist_unit(P, u - 256); else dft_unit(P, lds, u - 260);
      } else {
        const int ou = (u < 256) ? (1152 + u) : (u < 1092) ? (u - 324) : (u < 1476) ? (768 + (u - 1092)) : (1408 + (u - 1476));
        inproj_unit(P, lds, ou);
        if (u < 256) {
          asm volatile("s_waitcnt vmcnt(0)" ::: "memory");
          __syncthreads();
          if (threadIdx.x == 0) {
            __builtin_amdgcn_fence(__ATOMIC_RELEASE, "agent");
            asm volatile("s_waitcnt vmcnt(0)" ::: "memory");
            xb_add(&P.counters[32 + ((u & 63) >> 4)], 1u);
          }
        }
      }
    }
  PHASE_END
  PHASE_BEGIN(3) FOR_UNITS(768) { USYNC attn_unit(P, lds, u); } PHASE_END
  PHASE_BEGIN(4) for (int rep = 0; rep < DBG_REPG; ++rep) FOR_UNITS(512) { USYNC outproj_unit(P, lds, u, P.wt_out0, P.x, 0); } PHASE_END
  PHASE_BEGIN(5) for (int rep = 0; rep < DBG_REP5; ++rep) phase_router(P, lds, 0); PHASE_END
#define TOPK_AND_CVT(first, count) do { if (ubase < 64) { FOR_UNITS(64) { USYNC topk_unit(P, lds, u); } } \
    else { USYNC cvt_stream(P, lds, CVT_SMALL + CVT_MOE_PER_LAYER + (first) + (ubase - 64), (int)gridDim.x - 64, CVT_SMALL + CVT_MOE_PER_LAYER + (first) + (count)); } } while (0)
  PHASE_BEGIN(6) TOPK_AND_CVT(0, CVT_MOE_PER_LAYER / 2); PHASE_END
  PHASE_BEGIN(7) for (int rep = 0; rep < DBG_REP7; ++rep) FOR_UNITS(2048) { USYNC moe_gu_unit(P, lds, u, 0); } PHASE_END
  PHASE_BEGIN(8) for (int rep = 0; rep < DBG_REPD; ++rep) FOR_UNITS(1024) { USYNC moe_down_unit(P, lds, u, 0); } PHASE_END
  PHASE_BEGIN(9) phase_modulate(P, P.out, 1, false, 0); PHASE_END
  PHASE_BEGIN(10) for (int rep = 0; rep < DBG_REPG; ++rep) FOR_UNITS(1536) { USYNC convin_unit(P, lds, u); } PHASE_END
  PHASE_BEGIN(11) for (int rep = 0; rep < DBG_REPS; ++rep) phase_conv(P); PHASE_END
  PHASE_BEGIN(12) FOR_UNITS(512) { USYNC outproj_unit(P, lds, u, P.wt_cout, (const float*)nullptr, 1); } PHASE_END
  PHASE_BEGIN(13) for (int rep = 0; rep < DBG_REP5; ++rep) phase_router(P, lds, 1); PHASE_END
  PHASE_BEGIN(14) TOPK_AND_CVT(CVT_MOE_PER_LAYER / 2, CVT_MOE_PER_LAYER - CVT_MOE_PER_LAYER / 2); PHASE_END
  PHASE_BEGIN(15) FOR_UNITS(2048) { USYNC moe_gu_unit(P, lds, u, 1); } PHASE_END
  PHASE_BEGIN(16) for (int rep = 0; rep < DBG_REPD; ++rep) FOR_UNITS(1024) { USYNC moe_down_unit(P, lds, u, 1); } PHASE_END
  PHASE_BEGIN(17) phase_combine(P, 1); PHASE_END
}

extern "C" void kernel_launch(void* const* d_in, const int* in_sizes, int n_in, void* d_out, int out_size, void* d_ws, size_t ws_size, hipStream_t stream) {
  (void)in_sizes; (void)n_in; (void)out_size; (void)ws_size;
  static int grid_blocks = 0;
  if (!grid_blocks) {
    int dev = 0, cus = 0, per_cu = 0;
    hipGetDevice(&dev);
    hipDeviceGetAttribute(&cus, hipDeviceAttributeMultiprocessorCount, dev);
    if (hipFuncSetAttribute((const void*)fwd_megakernel, hipFuncAttributeMaxDynamicSharedMemorySize, LDS_TOTAL) != hipSuccess) fprintf(stderr, "hipFuncSetAttribute failed\n");
    hipOccupancyMaxActiveBlocksPerMultiprocessor(&per_cu, (const void*)fwd_megakernel, NTHREADS, LDS_TOTAL);
    if (per_cu < 1) per_cu = 1;
    grid_blocks = cus * per_cu;
  }
  Params p{};
  const float* const* in = (const float* const*)d_in;
  p.x = in[0]; p.c = in[1]; p.ctx = in[2]; p.c_ctx = in[3]; p.ada_w = in[4]; p.ada_b = in[5]; p.norm_mix = in[6]; p.norm_ffn = in[7];
  p.attn_w_in = in[8]; p.q_norm = in[9]; p.k_norm = in[10]; p.lam_q1 = in[11]; p.lam_k1 = in[12]; p.lam_q2 = in[13]; p.lam_k2 = in[14];
  p.subln = in[15]; p.attn_w_out = in[16]; p.conv_w_in = in[17]; p.conv_w = in[18]; p.conv_w_out = in[19]; p.router_w = in[20];
  p.moe_gate = in[21]; p.moe_up = in[22]; p.moe_down = in[23];
  p.out = (float*)d_out;
  char* w = (char*)d_ws;
  size_t off = 0;
  auto take = [&](size_t bytes) { char* r = w + off; off += (bytes + 255) & ~(size_t)255; return r; };
  p.counters = (unsigned*)take(XCD_BAR_WORDS * 4);
  p.mods = (float*)take((size_t)2 * 5 * 6144 * 4);
  p.rope = (float*)take(2048 * 4);
  p.aff = (float*)take((size_t)64 * 4096 * 4);
  p.gate = (float*)take((size_t)64 * 512 * 4);
  p.idx = (int*)take((size_t)64 * 512 * 4);
  p.inv = (int*)take((size_t)16384 * 16 * 4);
  p.wt_in0 = (bf16_t*)take((size_t)2816 * 1024 * 2);
  p.wt_out0 = (bf16_t*)take((size_t)1024 * 1024 * 2);
  p.wt_cin = (bf16_t*)take((size_t)3072 * 1024 * 2);
  p.wt_cout = (bf16_t*)take((size_t)1024 * 1024 * 2);
  p.wt_gu = (bf16_t*)take((size_t)32 * 2048 * 1024 * 2);
  p.wt_d = (bf16_t*)take((size_t)32 * 1024 * 1024 * 2);
  p.dft = (bf16_t*)take((size_t)4096 * 8192 * 2);
  p.XB = (bf16_t*)take((size_t)16384 * 1024 * 2);
  p.Y = p.dft;
  p.H = (bf16_t*)take((size_t)16384 * 1024 * 2);
  p.HC = (bf16_t*)take((size_t)1024 * 1024 * 2);
  p.OCAT = (bf16_t*)take((size_t)16384 * 1024 * 2);
  p.A2 = (bf16_t*)take((size_t)64 * 512 * 1024 * 2);
  char* l0 = take((size_t)16384 * 768 * 2 + (size_t)4 * 4352 * 768 * 2 * 2 + (size_t)4 * 256 * 8192 * 2);
  p.Q = (bf16_t*)l0;
  p.Kb = (bf16_t*)(l0 + (size_t)16384 * 768 * 2);
  p.Vt = (bf16_t*)(l0 + (size_t)16384 * 768 * 2 + (size_t)4 * 4352 * 768 * 2);
  p.Zt = (bf16_t*)(l0 + (size_t)16384 * 768 * 2 + (size_t)4 * 4352 * 768 * 2 * 2);
  p.Zc = (bf16_t*)l0;
  p.BG = (bf16_t*)(l0 + (size_t)16384 * 1024 * 2);
  hipMemsetAsync(p.counters, 0, XCD_BAR_WORDS * 4, stream);
#if SINGLE_LAUNCH
  p.phase_lo = 0; p.phase_hi = DBG_PHASE_HI;
  void* args[] = {&p};
  hipError_t e = hipLaunchCooperativeKernel((void*)fwd_megakernel, dim3(grid_blocks), dim3(NTHREADS), args, LDS_TOTAL, stream);
  if (e != hipSuccess) fprintf(stderr, "cooperative launch failed: %s (grid %d)\n", hipGetErrorString(e), grid_blocks);
#else
  for (int ph = 0; ph < NPHASES; ++ph) {
    p.phase_lo = ph; p.phase_hi = ph + 1;
    fwd_megakernel<<<dim3(grid_blocks), dim3(NTHREADS), LDS_TOTAL, stream>>>(p);
  }
#endif
}
```

```cpp
#include <hip/hip_runtime.h>
#include <hip/hip_cooperative_groups.h>
#include <cstdio>
#include <cstdint>
namespace cg = cooperative_groups;

#ifndef SINGLE_LAUNCH
#define SINGLE_LAUNCH 1
#endif

typedef unsigned short bf16_t;
typedef short bf16x8 __attribute__((ext_vector_type(8)));
typedef float f32x4 __attribute__((ext_vector_type(4)));
typedef unsigned u32x4 __attribute__((ext_vector_type(4)));
typedef unsigned u32x2 __attribute__((ext_vector_type(2)));

#define NTHREADS 512
#define EPSV 1e-6f
#define NPHASES 18
#ifndef DBG_OUTK
#define DBG_OUTK 1024
#endif
#ifndef DBG_REP7
#define DBG_REP7 1
#endif
#ifndef DBG_REP3
#define DBG_REP3 1
#endif
#ifndef DBG_REP0
#define DBG_REP0 1
#endif
#ifndef DBG_REP5
#define DBG_REP5 1
#endif
#ifndef DBG_REPG
#define DBG_REPG 1
#endif
#ifndef DBG_REPS
#define DBG_REPS 1
#endif
#ifndef DBG_REPD
#define DBG_REPD 1
#endif
#ifndef DBG_PHASE_HI
#define DBG_PHASE_HI NPHASES
#endif
#define LDS_BYTES 147456
#define LDS_TOTAL (147456 + 256)

struct Params {
  const float *x, *c, *ctx, *c_ctx, *ada_w, *ada_b, *norm_mix, *norm_ffn, *attn_w_in, *q_norm, *k_norm,
      *lam_q1, *lam_k1, *lam_q2, *lam_k2, *subln, *attn_w_out, *conv_w_in, *conv_w, *conv_w_out,
      *router_w, *moe_gate, *moe_up, *moe_down;
  float* out;
  bf16_t *wt_in0, *wt_out0, *wt_cin, *wt_cout, *wt_gu, *wt_d, *dft, *H, *HC, *Q, *Kb, *Vt, *Zt, *OCAT, *A2, *Zc, *BG;
  float *mods, *rope, *aff, *gate;
  int* idx;
  int* inv;
  bf16_t* Y;
  bf16_t* XB;
  unsigned* counters;
  int phase_lo, phase_hi;
};

typedef __bf16 bf16x2_t __attribute__((ext_vector_type(2)));
typedef float f32x2_t __attribute__((ext_vector_type(2)));
__device__ __forceinline__ unsigned pk_bf16(float lo, float hi) {
  const f32x2_t v = {lo, hi};
  const bf16x2_t r = __builtin_convertvector(v, bf16x2_t);
  return __builtin_bit_cast(unsigned, r);
}
__device__ __forceinline__ float bf2f(unsigned short v) { return __uint_as_float(((unsigned)v) << 16); }
__device__ __forceinline__ float wave_sum(float v) {
#pragma unroll
  for (int o = 32; o > 0; o >>= 1) v += __shfl_xor(v, o);
  return v;
}
__device__ __forceinline__ f32x4 mfma16(bf16x8 a, bf16x8 b, f32x4 c) { return __builtin_amdgcn_mfma_f32_16x16x32_bf16(a, b, c, 0, 0, 0); }

__device__ __forceinline__ int otid() { int t = threadIdx.x; asm volatile("" : "+v"(t)); return t; }

__device__ __forceinline__ int next_unit(unsigned* ctr, int* s_unit) {
  __syncthreads();
  if (threadIdx.x == 0) *s_unit = (int)atomicAdd(ctr, 1u);
  __syncthreads();
  return *s_unit;
}

#define LASP __attribute__((address_space(3)))
__device__ __forceinline__ void glds16(const bf16_t* g, char* l) {
  __builtin_amdgcn_global_load_lds((const unsigned*)g, (LASP unsigned*)l, 16, 0, 0);
}
__device__ __forceinline__ void gemm_mainloop(char* lds, const bf16_t* pa0, const bf16_t* pa1, const bf16_t* pb, size_t ldb, int K, f32x4 (&acc)[4][4]) {
  const int tid = otid(), lane = tid & 63, wave = tid >> 6, wm = wave >> 2, wn = wave & 3, l15 = lane & 15, quad = lane >> 4;
  const int wu = __builtin_amdgcn_readfirstlane(wave);
#pragma unroll
  for (int m = 0; m < 4; ++m)
#pragma unroll
    for (int n = 0; n < 4; ++n) acc[m][n] = (f32x4){0.f, 0.f, 0.f, 0.f};
  const int nk = K >> 6;
  const bf16_t* pb1 = pb + 64 * ldb;
  const bf16_t* pb2 = pb + 128 * ldb;
  const bf16_t* pb3 = pb + 192 * ldb;
  char* lw = lds + wu * 1024;
#define GEMM_ISSUE(o, dst) do { glds16(pa0 + (o), (dst)); glds16(pa1 + (o), (dst) + 8192); glds16(pb + (o), (dst) + 16384); glds16(pb1 + (o), (dst) + 16384 + 8192); \
    glds16(pb2 + (o), (dst) + 16384 + 16384); glds16(pb3 + (o), (dst) + 16384 + 24576); } while (0)
  GEMM_ISSUE(0, lw);
  GEMM_ISSUE(64, lw + 49152);
  asm volatile("s_waitcnt vmcnt(6)" ::: "memory");
  __builtin_amdgcn_s_barrier();
  asm volatile("" ::: "memory");
  int aoff[2], boff[2];
#pragma unroll
  for (int ks = 0; ks < 2; ++ks) {
    const int sw = (((ks * 4 + quad) ^ ((l15 >> 1) & 7)) * 16);
    aoff[ks] = (wm * 64 + l15) * 128 + sw;
    boff[ks] = 16384 + (wn * 64 + l15) * 128 + sw;
  }
  bf16x8 af0[4], bf0[4], af1[4], bf1[4];
#pragma unroll
  for (int m = 0; m < 4; ++m) af0[m] = *(const bf16x8*)(lds + aoff[0] + m * 2048);
#pragma unroll
  for (int n = 0; n < 4; ++n) bf0[n] = *(const bf16x8*)(lds + boff[0] + n * 2048);
  int scur = 0;
  for (int kt = 0; kt < nk; ++kt) {
    const char* st = lds + scur * 49152;
    const bool has1 = (kt + 1 < nk), has2 = (kt + 2 < nk);
    int s1 = scur + 1; if (s1 >= 3) s1 -= 3;
    if (has2) {
      int s2 = scur + 2; if (s2 >= 3) s2 -= 3;
      char* nx = lw + s2 * 49152;
      const int o = (kt + 2) * 64;
      GEMM_ISSUE(o, nx);
    }
#pragma unroll
    for (int m = 0; m < 4; ++m) af1[m] = *(const bf16x8*)(st + aoff[1] + m * 2048);
#pragma unroll
    for (int n = 0; n < 4; ++n) bf1[n] = *(const bf16x8*)(st + boff[1] + n * 2048);
    __builtin_amdgcn_sched_barrier(0);
#pragma unroll
    for (int m = 0; m < 4; ++m)
#pragma unroll
      for (int n = 0; n < 4; ++n) acc[m][n] = mfma16(bf0[n], af0[m], acc[m][n]);
    __builtin_amdgcn_sched_barrier(0);
    if (has2) asm volatile("s_waitcnt vmcnt(6) lgkmcnt(0)" ::: "memory"); else asm volatile("s_waitcnt vmcnt(0) lgkmcnt(0)" ::: "memory");
    __builtin_amdgcn_s_barrier();
    asm volatile("" ::: "memory");
    if (has1) {
      const char* sn = lds + s1 * 49152;
#pragma unroll
      for (int m = 0; m < 4; ++m) af0[m] = *(const bf16x8*)(sn + aoff[0] + m * 2048);
#pragma unroll
      for (int n = 0; n < 4; ++n) bf0[n] = *(const bf16x8*)(sn + boff[0] + n * 2048);
    }
    __builtin_amdgcn_sched_barrier(0);
#pragma unroll
    for (int m = 0; m < 4; ++m)
#pragma unroll
      for (int n = 0; n < 4; ++n) acc[m][n] = mfma16(bf1[n], af1[m], acc[m][n]);
    __builtin_amdgcn_sched_barrier(0);
    scur = s1;
  }
  asm volatile("s_waitcnt lgkmcnt(0)" ::: "memory");
  __builtin_amdgcn_s_barrier();
  asm volatile("" ::: "memory");
#undef GEMM_ISSUE
}

__device__ __forceinline__ f32x4 load4_bf16(const bf16_t* p) {
  const u32x2 w = *(const u32x2*)p;
  return (f32x4){__uint_as_float(w.x << 16), __uint_as_float(w.x & 0xffff0000u), __uint_as_float(w.y << 16), __uint_as_float(w.y & 0xffff0000u)};
}
__device__ __forceinline__ void store4_bf16(bf16_t* p, f32x4 v) {
  u32x2 w;
  w.x = pk_bf16(v[0], v[1]);
  w.y = pk_bf16(v[2], v[3]);
  *(u32x2*)p = w;
}

#define P0_GEMV 384
#define P0_DFT 256
#define P0_FOLD 128
#define P0_ROPE 1
#define P0_CVT CVT_SMALL
#define P0_TOTAL (P0_GEMV + P0_DFT + P0_FOLD + P0_ROPE + P0_CVT)

__device__ void p0_gemv(const Params& P, char* lds, int u) {
  const int tid = otid();
  const int l = u / 192, cb = u % 192, col0 = cb * 32;
  float* sc = (float*)lds;
  float* red = (float*)(lds + 20480);
  for (int i = tid; i < 5 * 1024; i += NTHREADS) {
    const int r = i >> 10, k = i & 1023;
    const float v = (r < 4) ? P.c[r * 1024 + k] : P.c_ctx[k];
    sc[i] = v / (1.f + __expf(-v));
  }
  __syncthreads();
  const int col = tid & 31, kp = tid >> 5;
  float a0 = 0.f, a1 = 0.f, a2 = 0.f, a3 = 0.f, a4 = 0.f;
  const float* w = P.ada_w + ((size_t)l * 1024 + kp * 64) * 6144 + col0 + col;
#pragma unroll 16
  for (int k = 0; k < 64; ++k) {
    const float wv = w[(size_t)k * 6144];
    const int kk = kp * 64 + k;
    a0 += sc[kk] * wv; a1 += sc[1024 + kk] * wv; a2 += sc[2048 + kk] * wv; a3 += sc[3072 + kk] * wv; a4 += sc[4096 + kk] * wv;
  }
  red[(kp * 5 + 0) * 32 + col] = a0; red[(kp * 5 + 1) * 32 + col] = a1; red[(kp * 5 + 2) * 32 + col] = a2;
  red[(kp * 5 + 3) * 32 + col] = a3; red[(kp * 5 + 4) * 32 + col] = a4;
  __syncthreads();
  if (tid < 160) {
    const int r = tid >> 5, cc = tid & 31;
    float sum = 0.f;
#pragma unroll
    for (int q = 0; q < 16; ++q) sum += red[(q * 5 + r) * 32 + cc];
    P.mods[((size_t)l * 5 + r) * 6144 + col0 + cc] = sum + P.ada_b[l * 6144 + col0 + cc];
  }
}

__device__ void p0_dft(const Params& P, char* lds, int u) {
  const int tid = otid();
  float* tab = (float*)lds;
  for (int i = tid; i < 4096; i += NTHREADS) tab[i] = cospif((float)i * (1.f / 2048.f));
  __syncthreads();
  for (int kr = 0; kr < 8; ++kr) {
    const int k = u * 8 + kr;
    unsigned cw[4], sw[4];
#pragma unroll
    for (int i = 0; i < 4; ++i) {
      const int n0 = tid * 8 + 2 * i;
      const int p0 = (k * n0) & 4095, p1 = (k * (n0 + 1)) & 4095;
      cw[i] = pk_bf16(tab[p0], tab[p1]);
      sw[i] = pk_bf16(tab[(p0 + 1024) & 4095], tab[(p1 + 1024) & 4095]);
    }
    *(u32x4*)(P.dft + (size_t)k * 8192 + tid * 8) = (u32x4){cw[0], cw[1], cw[2], cw[3]};
    *(u32x4*)(P.dft + (size_t)k * 8192 + 4096 + tid * 8) = (u32x4){sw[0], sw[1], sw[2], sw[3]};
  }
}

__device__ void p0_fold(const Params& P, char* lds, int u) {
  const int tid = otid();
  float* tab = (float*)lds;
  float* wl = (float*)(lds + 256);
  const int k0 = u * 8;
  if (tid < 64) tab[tid] = cospif((float)tid * (1.f / 32.f));
  {
    const int r = tid >> 6, c4 = (tid & 63) * 4;
    *(f32x4*)(wl + r * 256 + c4) = *(const f32x4*)(P.attn_w_in + (size_t)(k0 + r) * 2560 + 2304 + c4);
  }
  __syncthreads();
  const int col = tid & 255, kh = tid >> 8, g = col >> 6, cp = col & 63;
  float sa[4] = {0.f, 0.f, 0.f, 0.f}, sb[4] = {0.f, 0.f, 0.f, 0.f};
#pragma unroll 4
  for (int c = 0; c < 64; ++c) {
    const int ph = (c * cp) & 63;
    const float tc = tab[ph], ts = tab[(ph + 48) & 63];
#pragma unroll
    for (int j = 0; j < 4; ++j) { const float w = wl[(kh * 4 + j) * 256 + g * 64 + c]; sa[j] += w * tc; sb[j] += w * ts; }
  }
  u32x2 wa, wb;
  wa.x = pk_bf16(sa[0], sa[1]); wa.y = pk_bf16(sa[2], sa[3]); wb.x = pk_bf16(sb[0], sb[1]); wb.y = pk_bf16(sb[2], sb[3]);
  *(u32x2*)(P.wt_in0 + (size_t)(2304 + col) * 1024 + k0 + kh * 4) = wa;
  *(u32x2*)(P.wt_in0 + (size_t)(2560 + col) * 1024 + k0 + kh * 4) = wb;
}

__device__ void p0_rope(const Params& P) {
  for (int i = threadIdx.x; i < 1024; i += NTHREADS) {
    const int pos = i >> 4, j = i & 15;
    const float inv = powf(10000.f, -(float)j / 16.f);
    const float ang = (float)pos * inv;
    P.rope[i] = cosf(ang);
    P.rope[1024 + i] = sinf(ang);
  }
}

#define CVT_SMALL 464
#define CVT_GU_PER 128
#define CVT_D_PER 64
#define CVT_MOE_PER_LAYER (16 * (CVT_GU_PER + CVT_D_PER))
__device__ __forceinline__ void cvt_decode(const Params& P, int t, int tid, const float*& sp, int& ld, bf16_t*& dp) {
  const float *p0, *p1;
  bf16_t* dst;
  int type;
  if (t < 144) { p0 = P.attn_w_in; p1 = p0; dst = P.wt_in0; ld = 2560; type = 0; }
  else if (t < 208) { t -= 144; p0 = P.attn_w_out; p1 = p0; dst = P.wt_out0; ld = 1024; type = 0; }
  else if (t < 336) { t -= 208; p0 = P.conv_w_in + 1024; p1 = P.conv_w_in + 2048; dst = P.wt_cin; ld = 3072; type = 1; }
  else if (t < 400) { t -= 336; p0 = P.conv_w_in; p1 = p0; dst = P.wt_cin + (size_t)2048 * 1024; ld = 3072; type = 0; }
  else if (t < 464) { t -= 400; p0 = P.conv_w_out; p1 = p0; dst = P.wt_cout; ld = 1024; type = 0; }
  else {
    t -= 464;
    const int layer = t / CVT_MOE_PER_LAYER; t -= layer * CVT_MOE_PER_LAYER;
    if (t < 16 * CVT_GU_PER) { const int mat = layer * 16 + t / CVT_GU_PER; t %= CVT_GU_PER; p0 = P.moe_gate + (size_t)mat * 1048576; p1 = P.moe_up + (size_t)mat * 1048576;
      dst = P.wt_gu + (size_t)mat * 2048 * 1024; ld = 1024; type = 1; }
    else { t -= 16 * CVT_GU_PER; const int mat = layer * 16 + t / CVT_D_PER; t %= CVT_D_PER; p0 = P.moe_down + (size_t)mat * 1048576; p1 = p0; dst = P.wt_d + (size_t)mat * 1048576; ld = 1024; type = 0; }
  }
  const int rb = t >> 2, kq = t & 3;
  {
    const int k = tid >> 3, ch = tid & 7;
    const int r = rb * 64 + ch * 8;
    const float* src;
    int col;
    if (type == 0) { src = p0; col = r; }
    else { const int j = r >> 8, q = (r & 255) >> 4, w = r & 15; col = j * 128 + (q >> 1) * 16 + w; src = (q & 1) ? p1 : p0; }
    sp = src + (size_t)(kq * 256 + k) * ld + col;
  }
  {
    const int n = tid >> 3, kc = tid & 7;
    dp = dst + (size_t)(rb * 64 + n) * 1024 + kq * 256 + kc * 8;
  }
}
__device__ __forceinline__ void cvt_load(const float* sp, int ld, f32x4 (&v)[4][2]) {
#pragma unroll
  for (int sb = 0; sb < 4; ++sb) { v[sb][0] = *(const f32x4*)(sp + (size_t)sb * 64 * ld); v[sb][1] = *(const f32x4*)(sp + (size_t)sb * 64 * ld + 4); }
}
__device__ __forceinline__ void cvt_finish(char* lds, int tid, bf16_t* dp, const f32x4 (&v)[4][2]) {
  float* tile = (float*)lds;
  {
    const int k = tid >> 3, ch = tid & 7;
#pragma unroll
    for (int sb = 0; sb < 4; ++sb) {
      float* tp = tile + sb * 4160 + k * 65 + ch * 8;
      tp[0] = v[sb][0][0]; tp[1] = v[sb][0][1]; tp[2] = v[sb][0][2]; tp[3] = v[sb][0][3]; tp[4] = v[sb][1][0]; tp[5] = v[sb][1][1]; tp[6] = v[sb][1][2]; tp[7] = v[sb][1][3];
    }
  }
  __syncthreads();
  {
    const int n = tid >> 3, kc = tid & 7;
#pragma unroll
    for (int sb = 0; sb < 4; ++sb) {
      const float* tp = tile + sb * 4160 + (kc * 8) * 65 + n;
      u32x4 w;
      w.x = pk_bf16(tp[0], tp[65]); w.y = pk_bf16(tp[130], tp[195]); w.z = pk_bf16(tp[260], tp[325]); w.w = pk_bf16(tp[390], tp[455]);
      *(u32x4*)(dp + sb * 64) = w;
    }
  }
}
__device__ __forceinline__ void cvt_stream(const Params& P, char* lds, int tfirst, int tstride, int tend) {
  const int tid = otid();
  if (tfirst >= tend) return;
  const float* sp; int ld; bf16_t* dp;
  f32x4 va[4][2], vb[4][2];
  cvt_decode(P, tfirst, tid, sp, ld, dp);
  cvt_load(sp, ld, va);
  for (int t = tfirst; t < tend; t += tstride) {
    const int tn = t + tstride;
    const bool more = tn < tend;
    bf16_t* dpn = dp;
    if (more) { const float* spn; int ldn; cvt_decode(P, tn, tid, spn, ldn, dpn); cvt_load(spn, ldn, vb); }
    __syncthreads();
    cvt_finish(lds, tid, dp, va);
    if (more) {
#pragma unroll
      for (int sb = 0; sb < 4; ++sb) { va[sb][0] = vb[sb][0]; va[sb][1] = vb[sb][1]; }
      dp = dpn;
    }
  }
}

__device__ __forceinline__ void cvt_one(const Params& P, char* lds, int t) {
  const int tid = otid();
  const float* sp; int ld; bf16_t* dp;
  f32x4 v[4][2];
  cvt_decode(P, t, tid, sp, ld, dp);
  cvt_load(sp, ld, v);
  cvt_finish(lds, tid, dp, v);
}

__device__ __forceinline__ void moe_combine_rows2(const Params& P, int l, int row0, int lane, f32x4 (&v)[2][4]) {
  const int b = row0 >> 12;
  int myslot[2];
#pragma unroll
  for (int rr = 0; rr < 2; ++rr) myslot[rr] = P.inv[(size_t)(row0 + rr) * 16 + (lane & 15)];
  f32x4 a[2][4];
  unsigned mask[2];
#pragma unroll
  for (int rr = 0; rr < 2; ++rr) {
#pragma unroll
    for (int j = 0; j < 4; ++j) a[rr][j] = (f32x4){0.f, 0.f, 0.f, 0.f};
    mask[rr] = (unsigned)(__ballot(myslot[rr] >= 0) & 0xffffull);
  }
  while (mask[0] | mask[1]) {
    int ee[2][2], sl[2][2]; float vl[2][2];
#pragma unroll
    for (int rr = 0; rr < 2; ++rr)
#pragma unroll
      for (int k = 0; k < 2; ++k) {
        if (mask[rr]) { ee[rr][k] = __builtin_ctz(mask[rr]); mask[rr] &= mask[rr] - 1u; sl[rr][k] = __builtin_amdgcn_readlane(myslot[rr], ee[rr][k]); vl[rr][k] = 1.f; }
        else { ee[rr][k] = 0; sl[rr][k] = 0; vl[rr][k] = 0.f; }
      }
    float gt[2][2]; unsigned w[2][2][4];
#pragma unroll
    for (int rr = 0; rr < 2; ++rr)
#pragma unroll
      for (int k = 0; k < 2; ++k) {
        const int be = b * 16 + ee[rr][k];
        gt[rr][k] = P.gate[be * 512 + sl[rr][k]] * vl[rr][k];
        const unsigned char* yp = (const unsigned char*)P.Y + ((size_t)be * 512 + sl[rr][k]) * 1024 + lane * 4;
#pragma unroll
        for (int j = 0; j < 4; ++j) w[rr][k][j] = *(const unsigned*)(yp + j * 256);
      }
#pragma unroll
    for (int rr = 0; rr < 2; ++rr)
#pragma unroll
      for (int k = 0; k < 2; ++k)
#pragma unroll
        for (int j = 0; j < 4; ++j) {
          const int wv_ = (int)w[rr][k][j];
          a[rr][j][0] += gt[rr][k] * __builtin_amdgcn_cvt_f32_fp8(wv_, 0); a[rr][j][1] += gt[rr][k] * __builtin_amdgcn_cvt_f32_fp8(wv_, 1);
          a[rr][j][2] += gt[rr][k] * __builtin_amdgcn_cvt_f32_fp8(wv_, 2); a[rr][j][3] += gt[rr][k] * __builtin_amdgcn_cvt_f32_fp8(wv_, 3);
        }
  }
  const float* gf = P.mods + ((size_t)l * 5 + b) * 6144 + 5120;
#pragma unroll
  for (int j = 0; j < 4; ++j) {
    const f32x4 g = *(const f32x4*)(gf + j * 256 + lane * 4);
    v[0][j] += g * a[0][j]; v[1][j] += g * a[1][j];
  }
}

__device__ void phase_combine(const Params& P, int l) {
  const int tid_ = otid(); const int lane = tid_ & 63, wave = tid_ >> 6;
  for (int row0 = (blockIdx.x * 8 + wave) * 2; row0 < 16384; row0 += gridDim.x * 16) {
    const bf16_t* src = P.XB + (size_t)row0 * 1024;
    float* dstf = P.out + (size_t)row0 * 1024;
    f32x4 v[2][4];
#pragma unroll
    for (int rr = 0; rr < 2; ++rr)
#pragma unroll
      for (int j = 0; j < 4; ++j) v[rr][j] = load4_bf16(src + rr * 1024 + j * 256 + lane * 4);
    moe_combine_rows2(P, l, row0, lane, v);
#pragma unroll
    for (int rr = 0; rr < 2; ++rr)
#pragma unroll
      for (int j = 0; j < 4; ++j) *(f32x4*)(dstf + rr * 1024 + j * 256 + lane * 4) = v[rr][j];
  }
}

__device__ void phase_modulate(const Params& P, const float* xin, int l, bool with_ctx, int comb_l) {
  const int tid_ = otid(); const int lane = tid_ & 63, wave = tid_ >> 6;
  const int nrows = with_ctx ? 17408 : 16384;
  for (int row0 = (blockIdx.x * 8 + wave) * 2; row0 < nrows; row0 += gridDim.x * 16) {
    const float* src; bf16_t* dst; int mr;
    if (row0 < 16384) { src = xin + (size_t)row0 * 1024; dst = P.H + (size_t)row0 * 1024; mr = row0 >> 12; }
    else { src = P.ctx + (size_t)(row0 - 16384) * 1024; dst = P.HC + (size_t)(row0 - 16384) * 1024; mr = 4; }
    f32x4 v[2][4];
    if (comb_l >= 0) {
#pragma unroll
      for (int rr = 0; rr < 2; ++rr)
#pragma unroll
        for (int j = 0; j < 4; ++j) v[rr][j] = load4_bf16(P.XB + (size_t)(row0 + rr) * 1024 + j * 256 + lane * 4);
      moe_combine_rows2(P, comb_l, row0, lane, v);
#pragma unroll
      for (int rr = 0; rr < 2; ++rr)
#pragma unroll
        for (int j = 0; j < 4; ++j) {
          store4_bf16(P.XB + (size_t)(row0 + rr) * 1024 + j * 256 + lane * 4, v[rr][j]);
        }
    } else {
#pragma unroll
      for (int rr = 0; rr < 2; ++rr)
#pragma unroll
        for (int j = 0; j < 4; ++j) v[rr][j] = *(const f32x4*)(src + rr * 1024 + j * 256 + lane * 4);
    }
    float rinv[2];
#pragma unroll
    for (int rr = 0; rr < 2; ++rr) {
      float ss = 0.f;
#pragma unroll
      for (int j = 0; j < 4; ++j) ss += v[rr][j][0] * v[rr][j][0] + v[rr][j][1] * v[rr][j][1] + v[rr][j][2] * v[rr][j][2] + v[rr][j][3] * v[rr][j][3];
      ss = wave_sum(ss);
      rinv[rr] = rsqrtf(ss * (1.f / 1024.f) + EPSV);
    }
    const float* md = P.mods + ((size_t)l * 5 + mr) * 6144;
#pragma unroll
    for (int j = 0; j < 4; ++j) {
      const int col = j * 256 + lane * 4;
      const f32x4 g = *(const f32x4*)(P.norm_mix + l * 1024 + col), sh = *(const f32x4*)(md + col), sc = *(const f32x4*)(md + 1024 + col);
#pragma unroll
      for (int rr = 0; rr < 2; ++rr) {
        f32x4 y;
#pragma unroll
        for (int i = 0; i < 4; ++i) y[i] = (v[rr][j][i] * rinv[rr] * g[i]) * (1.f + sc[i]) + sh[i];
        store4_bf16(dst + rr * 1024 + col, y);
      }
    }
  }
}

__device__ void phase_router(const Params& P, char* lds, int l) {
  const int tid = otid(); const int lane = tid & 63, wave = tid >> 6;
  float* wl = (float*)lds;
  __syncthreads();
  for (int i = tid; i < 4096; i += NTHREADS) {
    const int d = i >> 2, q = i & 3;
    const f32x4 w = *(const f32x4*)(P.router_w + ((size_t)l * 1024 + d) * 16 + q * 4);
    wl[(q * 4 + 0) * 1024 + d] = w[0]; wl[(q * 4 + 1) * 1024 + d] = w[1]; wl[(q * 4 + 2) * 1024 + d] = w[2]; wl[(q * 4 + 3) * 1024 + d] = w[3];
  }
  __syncthreads();
  for (int row0 = (blockIdx.x * 8 + wave) * 2; row0 < 16384; row0 += gridDim.x * 16) {
    const int b = row0 >> 12;
    f32x4 v[2][4];
    float rinv[2];
#pragma unroll
    for (int rr = 0; rr < 2; ++rr) {
      const bf16_t* src = P.XB + (size_t)(row0 + rr) * 1024;
#pragma unroll
      for (int j = 0; j < 4; ++j) v[rr][j] = load4_bf16(src + j * 256 + lane * 4);
    }
#pragma unroll
    for (int rr = 0; rr < 2; ++rr) {
      float ss = 0.f;
#pragma unroll
      for (int j = 0; j < 4; ++j) ss += v[rr][j][0] * v[rr][j][0] + v[rr][j][1] * v[rr][j][1] + v[rr][j][2] * v[rr][j][2] + v[rr][j][3] * v[rr][j][3];
      ss = wave_sum(ss);
      rinv[rr] = rsqrtf(ss * (1.f / 1024.f) + EPSV);
    }
    const float* md = P.mods + ((size_t)l * 5 + b) * 6144;
#pragma unroll
    for (int j = 0; j < 4; ++j) {
      const int col = j * 256 + lane * 4;
      const f32x4 g = *(const f32x4*)(P.norm_ffn + l * 1024 + col), sh = *(const f32x4*)(md + 3072 + col), sc = *(const f32x4*)(md + 4096 + col);
#pragma unroll
      for (int rr = 0; rr < 2; ++rr) {
#pragma unroll
        for (int i = 0; i < 4; ++i) v[rr][j][i] = (v[rr][j][i] * rinv[rr] * g[i]) * (1.f + sc[i]) + sh[i];
        store4_bf16(P.H + (size_t)(row0 + rr) * 1024 + col, v[rr][j]);
      }
    }
    float v32[32];
#pragma unroll
    for (int e = 0; e < 16; ++e) {
      float a0 = 0.f, a1 = 0.f;
#pragma unroll
      for (int j = 0; j < 4; ++j) {
        const f32x4 w = *(const f32x4*)(wl + e * 1024 + j * 256 + lane * 4);
        a0 += v[0][j][0] * w[0] + v[0][j][1] * w[1] + v[0][j][2] * w[2] + v[0][j][3] * w[3];
        a1 += v[1][j][0] * w[0] + v[1][j][1] * w[1] + v[1][j][2] * w[2] + v[1][j][3] * w[3];
      }
      v32[e] = a0; v32[16 + e] = a1;
      if (e & 1) __builtin_amdgcn_sched_barrier(0);
    }
    const bool b5 = (lane & 32) != 0, b4 = (lane & 16) != 0, b3 = (lane & 8) != 0, b2 = (lane & 4) != 0, b1 = (lane & 2) != 0;
    float w16[16];
#pragma unroll
    for (int i = 0; i < 16; ++i) { const float keep = b5 ? v32[i + 16] : v32[i], send = b5 ? v32[i] : v32[i + 16]; w16[i] = keep + __shfl_xor(send, 32); }
    float w8[8];
#pragma unroll
    for (int i = 0; i < 8; ++i) { const float keep = b4 ? w16[i + 8] : w16[i], send = b4 ? w16[i] : w16[i + 8]; w8[i] = keep + __shfl_xor(send, 16); }
    float w4[4];
#pragma unroll
    for (int i = 0; i < 4; ++i) { const float keep = b3 ? w8[i + 4] : w8[i], send = b3 ? w8[i] : w8[i + 4]; w4[i] = keep + __shfl_xor(send, 8); }
    float w2[2];
#pragma unroll
    for (int i = 0; i < 2; ++i) { const float keep = b2 ? w4[i + 2] : w4[i], send = b2 ? w4[i] : w4[i + 2]; w2[i] = keep + __shfl_xor(send, 4); }
    float z = (b1 ? w2[1] : w2[0]) + __shfl_xor(b1 ? w2[0] : w2[1], 2);
    z += __shfl_xor(z, 1);
    float mx = z;
    mx = fmaxf(mx, __shfl_xor(mx, 2)); mx = fmaxf(mx, __shfl_xor(mx, 4)); mx = fmaxf(mx, __shfl_xor(mx, 8)); mx = fmaxf(mx, __shfl_xor(mx, 16));
    const float ex = __expf(z - mx);
    float sum = ex;
    sum += __shfl_xor(sum, 2); sum += __shfl_xor(sum, 4); sum += __shfl_xor(sum, 8); sum += __shfl_xor(sum, 16);
    if ((lane & 1) == 0) {
      const int rr = lane >> 5, e = (lane >> 1) & 15, n = (row0 + rr) & 4095;
      P.aff[((size_t)b * 16 + e) * 4096 + n] = ex / sum;
    }
  }
}

__device__ void topk_unit(const Params& P, char* lds, int be) {
  const int tid = otid(), lane = tid & 63, wave = tid >> 6;
  unsigned* keys = (unsigned*)lds;
  unsigned* wsum = (unsigned*)(lds + 16384);
  const float* a = P.aff + (size_t)be * 4096;
  unsigned kv[8];
#pragma unroll
  for (int i = 0; i < 8; ++i) { kv[i] = __float_as_uint(a[tid * 8 + i]); keys[tid * 8 + i] = kv[i]; }
  unsigned prefix = 0;
  for (int bit = 31; bit >= 0; --bit) {
    const unsigned cand = prefix | (1u << bit);
    unsigned cnt = 0;
#pragma unroll
    for (int i = 0; i < 8; ++i) cnt += (kv[i] >= cand) ? 1u : 0u;
#pragma unroll
    for (int o = 32; o > 0; o >>= 1) cnt += __shfl_xor(cnt, o);
    __syncthreads();
    if (lane == 0) wsum[wave] = cnt;
    __syncthreads();
    unsigned tot = 0;
#pragma unroll
    for (int w = 0; w < 8; ++w) tot += wsum[w];
    if (tot >= 512u) prefix = cand;
  }
  unsigned gt = 0, eq = 0;
#pragma unroll
  for (int i = 0; i < 8; ++i) { gt += (kv[i] > prefix) ? 1u : 0u; eq += (kv[i] == prefix) ? 1u : 0u; }
  unsigned packed = gt | (eq << 16);
  unsigned incl = packed;
#pragma unroll
  for (int o = 1; o < 64; o <<= 1) { const unsigned t = __shfl_up(incl, o); if (lane >= o) incl += t; }
  __syncthreads();
  if (lane == 63) wsum[wave] = incl;
  __syncthreads();
  unsigned base = 0, total = 0;
#pragma unroll
  for (int w = 0; w < 8; ++w) { const unsigned s = wsum[w]; if (w < wave) base += s; total += s; }
  const unsigned excl = base + incl - packed;
  unsigned gpos = excl & 0xffffu, epos = excl >> 16;
  const unsigned ngt = total & 0xffffu;
  const unsigned need = 512u - ngt;
#pragma unroll
  for (int i = 0; i < 8; ++i) {
    const int n = tid * 8 + i;
    int slot = -1;
    if (kv[i] > prefix) { slot = (int)gpos; ++gpos; }
    else if (kv[i] == prefix) { if (epos < need) slot = (int)(ngt + epos); ++epos; }
    if (slot >= 0) { P.idx[be * 512 + slot] = n; P.gate[be * 512 + slot] = __uint_as_float(kv[i]); }
    P.inv[((size_t)(be >> 4) * 4096 + n) * 16 + (be & 15)] = slot;
  }
}

__device__ void phase_conv(const Params& P) {
  const size_t nitems = (size_t)2048 * 128;
  for (size_t it = (size_t)blockIdx.x * NTHREADS + threadIdx.x; it < nitems; it += (size_t)gridDim.x * NTHREADS) {
    const int tb = (int)(it >> 7), c0 = (int)(it & 127) * 8, t0 = tb * 8, n0 = t0 & 4095;
    u32x4 z[10], bg[8];
    z[0] = (u32x4){0, 0, 0, 0}; z[9] = (u32x4){0, 0, 0, 0};
    if (n0 > 0) z[0] = *(const u32x4*)(P.Zc + (size_t)(t0 - 1) * 1024 + c0);
#pragma unroll
    for (int r = 0; r < 8; ++r) { z[r + 1] = *(const u32x4*)(P.Zc + (size_t)(t0 + r) * 1024 + c0); bg[r] = *(const u32x4*)(P.BG + (size_t)(t0 + r) * 1024 + c0); }
    if (n0 + 8 < 4096) z[9] = *(const u32x4*)(P.Zc + (size_t)(t0 + 8) * 1024 + c0);
    float w0[8], w1[8], w2[8];
#pragma unroll
    for (int q = 0; q < 2; ++q) {
      const f32x4 a = *(const f32x4*)(P.conv_w + c0 + q * 4), b = *(const f32x4*)(P.conv_w + 1024 + c0 + q * 4), c = *(const f32x4*)(P.conv_w + 2048 + c0 + q * 4);
#pragma unroll
      for (int i = 0; i < 4; ++i) { w0[q * 4 + i] = a[i]; w1[q * 4 + i] = b[i]; w2[q * 4 + i] = c[i]; }
    }
#pragma unroll
    for (int r = 0; r < 8; ++r) {
      u32x4 o;
#pragma unroll
      for (int i = 0; i < 4; ++i) {
        const float lo = bf2f((unsigned short)(bg[r][i] & 0xffff)) * (w0[2 * i] * bf2f((unsigned short)(z[r][i] & 0xffff)) + w1[2 * i] * bf2f((unsigned short)(z[r + 1][i] & 0xffff)) + w2[2 * i] * bf2f((unsigned short)(z[r + 2][i] & 0xffff)));
        const float hi = bf2f((unsigned short)(bg[r][i] >> 16)) * (w0[2 * i + 1] * bf2f((unsigned short)(z[r][i] >> 16)) + w1[2 * i + 1] * bf2f((unsigned short)(z[r + 1][i] >> 16)) + w2[2 * i + 1] * bf2f((unsigned short)(z[r + 2][i] >> 16)));
        o[i] = pk_bf16(lo, hi);
      }
      *(u32x4*)(P.OCAT + (size_t)(t0 + r) * 1024 + c0) = o;
    }
  }
}

#define GEMM_PRE() const int tid = otid(), lane = tid & 63, wave = tid >> 6, wm = wave >> 2, wn = wave & 3, l15 = lane & 15, quad = lane >> 4, lr = tid >> 3, lc = ((tid & 7) ^ ((tid >> 4) & 7)) * 8;     \
  f32x4 acc[4][4]; (void)lane; (void)wm; (void)wn; (void)l15; (void)quad;

__device__ void inproj_unit(const Params& P, char* lds, int u) {
  GEMM_PRE();
  if (u < 768) {
    const int mt = u / 6, nt = u % 6;
    gemm_mainloop(lds, P.H + (size_t)(mt * 128 + lr) * 1024 + lc, P.H + (size_t)(mt * 128 + 64 + lr) * 1024 + lc, P.wt_in0 + (size_t)(nt * 256 + lr) * 1024 + lc, 1024, 1024, acc);
    const int nb = nt * 256 + wn * 64;
    const bool isq = nb < 768;
    const float* gn = isq ? P.q_norm : P.k_norm;
    f32x4 gv[4];
#pragma unroll
    for (int n = 0; n < 4; ++n) gv[n] = *(const f32x4*)(gn + n * 16 + quad * 4);
#pragma unroll
    for (int m = 0; m < 4; ++m) {
      const int t = mt * 128 + wm * 64 + m * 16 + l15, b = t >> 12, np = t & 4095, pr = np >> 6, pc = np & 63;
      float ss = 0.f;
#pragma unroll
      for (int n = 0; n < 4; ++n) ss += acc[m][n][0] * acc[m][n][0] + acc[m][n][1] * acc[m][n][1] + acc[m][n][2] * acc[m][n][2] + acc[m][n][3] * acc[m][n][3];
      ss += __shfl_xor(ss, 16); ss += __shfl_xor(ss, 32);
      const float rinv = rsqrtf(ss * (1.f / 64.f) + EPSV);
      const f32x4 cr = *(const f32x4*)(P.rope + pr * 16 + quad * 4), sr = *(const f32x4*)(P.rope + 1024 + pr * 16 + quad * 4);
      const f32x4 cc = *(const f32x4*)(P.rope + pc * 16 + quad * 4), sc = *(const f32x4*)(P.rope + 1024 + pc * 16 + quad * 4);
      f32x4 x0 = acc[m][0] * rinv * gv[0], x1 = acc[m][1] * rinv * gv[1], x2 = acc[m][2] * rinv * gv[2], x3 = acc[m][3] * rinv * gv[3];
      f32x4 y0 = x0 * cr - x1 * sr, y1 = x1 * cr + x0 * sr, y2 = x2 * cc - x3 * sc, y3 = x3 * cc + x2 * sc;
      bf16_t* dp;
      if (isq) { const float qs = 0.125f * 1.44269504f; y0 *= qs; y1 *= qs; y2 *= qs; y3 *= qs; dp = P.Q + (size_t)t * 768 + nb + quad * 4; }
      else dp = P.Kb + ((size_t)b * 4352 + np) * 768 + (nb - 768) + quad * 4;
      store4_bf16(dp, y0); store4_bf16(dp + 16, y1); store4_bf16(dp + 32, y2); store4_bf16(dp + 48, y3);
    }
  } else if (u < 1152) {
    const int id = u - 768, mt = id >> 6, nt = id & 63;
    gemm_mainloop(lds, P.wt_in0 + (size_t)(1536 + mt * 128 + lr) * 1024 + lc, P.wt_in0 + (size_t)(1536 + mt * 128 + 64 + lr) * 1024 + lc, P.H + (size_t)(nt * 256 + lr) * 1024 + lc, 1024, 1024, acc);
#pragma unroll
    for (int m = 0; m < 4; ++m) {
      const int c = mt * 128 + wm * 64 + m * 16 + l15;
#pragma unroll
      for (int n = 0; n < 4; ++n) {
        const int t = nt * 256 + wn * 64 + n * 16 + quad * 4, b = t >> 12, np = t & 4095;
        store4_bf16(P.Vt + ((size_t)b * 768 + c) * 4352 + (np & ~31) + quad * 8 + (n & 1) * 4, acc[m][n]);
      }
    }
  } else if (u < 1408) {
    const int id = u - 1152, mt = id >> 6, nt = id & 63;
    gemm_mainloop(lds, P.wt_in0 + (size_t)(2304 + mt * 128 + lr) * 1024 + lc, P.wt_in0 + (size_t)(2304 + mt * 128 + 64 + lr) * 1024 + lc, P.H + (size_t)(nt * 256 + lr) * 1024 + lc, 1024, 1024, acc);
#pragma unroll
    for (int m = 0; m < 4; ++m) {
      const int jj = mt * 128 + wm * 64 + m * 16 + l15, which = jj >> 8, cp = jj & 255;
#pragma unroll
      for (int n = 0; n < 4; ++n) {
        const int t = nt * 256 + wn * 64 + n * 16 + quad * 4, b = t >> 12, np = t & 4095;
        store4_bf16(P.Zt + ((size_t)b * 256 + cp) * 8192 + which * 4096 + np, acc[m][n]);
      }
    }
  } else if (u < 1432) {
    const int id = u - 1408, mt = id / 3, nt = id % 3;
    gemm_mainloop(lds, P.HC + (size_t)(mt * 128 + lr) * 1024 + lc, P.HC + (size_t)(mt * 128 + 64 + lr) * 1024 + lc, P.wt_in0 + (size_t)(768 + nt * 256 + lr) * 1024 + lc, 1024, 1024, acc);
    const int nb = nt * 256 + wn * 64;
    f32x4 gv[4];
#pragma unroll
    for (int n = 0; n < 4; ++n) gv[n] = *(const f32x4*)(P.k_norm + n * 16 + quad * 4);
#pragma unroll
    for (int m = 0; m < 4; ++m) {
      const int rr = mt * 128 + wm * 64 + m * 16 + l15, b = rr >> 8, j = rr & 255;
      float ss = 0.f;
#pragma unroll
      for (int n = 0; n < 4; ++n) ss += acc[m][n][0] * acc[m][n][0] + acc[m][n][1] * acc[m][n][1] + acc[m][n][2] * acc[m][n][2] + acc[m][n][3] * acc[m][n][3];
      ss += __shfl_xor(ss, 16); ss += __shfl_xor(ss, 32);
      const float rinv = rsqrtf(ss * (1.f / 64.f) + EPSV);
      bf16_t* dp = P.Kb + ((size_t)b * 4352 + 4096 + j) * 768 + nb + quad * 4;
#pragma unroll
      for (int n = 0; n < 4; ++n) store4_bf16(dp + n * 16, acc[m][n] * rinv * gv[n]);
    }
  } else {
    const int id = u - 1432, mt = id >> 2, nt = id & 3;
    gemm_mainloop(lds, P.wt_in0 + (size_t)(1536 + mt * 128 + lr) * 1024 + lc, P.wt_in0 + (size_t)(1536 + mt * 128 + 64 + lr) * 1024 + lc, P.HC + (size_t)(nt * 256 + lr) * 1024 + lc, 1024, 1024, acc);
#pragma unroll
    for (int m = 0; m < 4; ++m) {
      const int c = mt * 128 + wm * 64 + m * 16 + l15;
#pragma unroll
      for (int n = 0; n < 4; ++n) {
        const int rr = nt * 256 + wn * 64 + n * 16 + quad * 4, b = rr >> 8, j = rr & 255;
        store4_bf16(P.Vt + ((size_t)b * 768 + c) * 4352 + 4096 + (j & ~31) + quad * 8 + (n & 1) * 4, acc[m][n]);
      }
    }
  }
}

__device__ void dft_unit(const Params& P, char* lds, int id) {
  GEMM_PRE();
  const int b = id >> 4, mt = id & 15;
  const bf16_t* Bt = P.Zt + (size_t)b * 256 * 8192;
  gemm_mainloop(lds, P.dft + (size_t)(mt * 128 + lr) * 8192 + lc, P.dft + (size_t)(mt * 128 + 64 + lr) * 8192 + lc, Bt + (size_t)lr * 8192 + lc, 8192, 4096, acc);
  float* park = (float*)P.A2 + (size_t)id * 32768 + (size_t)tid * 4;
#pragma unroll
  for (int m = 0; m < 4; ++m)
#pragma unroll
    for (int n = 0; n < 4; ++n) *(f32x4*)(park + (m * 4 + n) * 2048) = acc[m][n];
  gemm_mainloop(lds, P.dft + (size_t)(mt * 128 + lr) * 8192 + 4096 + lc, P.dft + (size_t)(mt * 128 + 64 + lr) * 8192 + 4096 + lc, Bt + (size_t)lr * 8192 + 4096 + lc, 8192, 4096, acc);
#pragma unroll
  for (int m = 0; m < 4; ++m) {
    const int k = mt * 128 + wm * 64 + m * 16 + l15;
#pragma unroll
    for (int n = 0; n < 4; ++n) {
      const int col = 768 + wn * 64 + n * 16 + quad * 4;
      const f32x4 uu = *(const f32x4*)(park + (m * 4 + n) * 2048);
      store4_bf16(P.OCAT + ((size_t)b * 4096 + k) * 1024 + col, (uu + acc[m][n]) * (1.f / 512.f));
      if (k > 0) store4_bf16(P.OCAT + ((size_t)b * 4096 + (4096 - k)) * 1024 + col, (uu - acc[m][n]) * (1.f / 512.f));
    }
  }
}
__device__ void dft_nyquist_unit(const Params& P, int b) {
  const int tid = otid();
  const int cp = tid >> 1, half = tid & 1;
  const bf16_t* src = P.Zt + ((size_t)b * 256 + cp) * 8192 + half * 2048;
  float se = 0.f, so = 0.f;
#pragma unroll 8
  for (int i = 0; i < 256; ++i) {
    const u32x4 w = *(const u32x4*)(src + i * 8);
#pragma unroll
    for (int j = 0; j < 4; ++j) { se += __uint_as_float(w[j] << 16); so += __uint_as_float(w[j] & 0xffff0000u); }
  }
  float v = se - so;
  v += __shfl_xor(v, 1);
  if (half == 0) P.OCAT[((size_t)b * 4096 + 2048) * 1024 + 768 + cp] = (bf16_t)(pk_bf16(v * (1.f / 512.f), 0.f) & 0xffffu);
}

__device__ void outproj_unit(const Params& P, char* lds, int u, const bf16_t* Wt, const float* xin, int l) {
  GEMM_PRE();
  const int mt = u >> 2, nt = u & 3;
  gemm_mainloop(lds, P.OCAT + (size_t)(mt * 128 + lr) * 1024 + lc, P.OCAT + (size_t)(mt * 128 + 64 + lr) * 1024 + lc, Wt + (size_t)(nt * 256 + lr) * 1024 + lc, 1024, 1024, acc);
#pragma unroll
  for (int m = 0; m < 4; ++m) {
    const int t = mt * 128 + wm * 64 + m * 16 + l15, b = t >> 12;
#pragma unroll
    for (int n = 0; n < 4; ++n) {
      const int c = nt * 256 + wn * 64 + n * 16 + quad * 4;
      const f32x4 g = *(const f32x4*)(P.mods + ((size_t)l * 5 + b) * 6144 + 2048 + c);
      const f32x4 xv = xin ? *(const f32x4*)(xin + (size_t)t * 1024 + c) : load4_bf16(P.XB + (size_t)t * 1024 + c);
      store4_bf16(P.XB + (size_t)t * 1024 + c, xv + g * acc[m][n]);
    }
  }
}

__device__ __forceinline__ float silu_f(float v) { return v / (1.f + __expf(-v)); }

__device__ void moe_gu_unit(const Params& P, char* lds, int u, int l) {
  GEMM_PRE();
  const int mt = u & 3, b = (u >> 2) & 3, nt = (u >> 4) & 7, e = u >> 7, be = b * 16 + e;
  const int tok = P.idx[be * 512 + mt * 128 + lr], tok1 = P.idx[be * 512 + mt * 128 + 64 + lr];
  const bf16_t* Wt = P.wt_gu + ((size_t)(l * 16 + e) * 2048 + nt * 256) * 1024;
  gemm_mainloop(lds, P.H + ((size_t)b * 4096 + tok) * 1024 + lc, P.H + ((size_t)b * 4096 + tok1) * 1024 + lc, Wt + (size_t)lr * 1024 + lc, 1024, 1024, acc);
#pragma unroll
  for (int m = 0; m < 4; ++m) {
    const int rl = mt * 128 + wm * 64 + m * 16 + l15;
    bf16_t* dp = P.A2 + ((size_t)be * 512 + rl) * 1024 + nt * 128 + wn * 32 + quad * 4;
#pragma unroll
    for (int pp = 0; pp < 2; ++pp) {
      f32x4 a;
#pragma unroll
      for (int r = 0; r < 4; ++r) a[r] = silu_f(acc[m][2 * pp][r]) * acc[m][2 * pp + 1][r];
      store4_bf16(dp + pp * 16, a);
    }
  }
}

__device__ void moe_down_unit(const Params& P, char* lds, int u, int l) {
  GEMM_PRE();
  const int mt = u & 3, b = (u >> 2) & 3, nt = (u >> 4) & 3, e = u >> 6, be = b * 16 + e;
  const bf16_t* Wt = P.wt_d + ((size_t)(l * 16 + e) * 1024 + nt * 256) * 1024;
  gemm_mainloop(lds, P.A2 + ((size_t)be * 512 + mt * 128 + lr) * 1024 + lc, P.A2 + ((size_t)be * 512 + mt * 128 + 64 + lr) * 1024 + lc, Wt + (size_t)lr * 1024 + lc, 1024, 1024, acc);
#pragma unroll
  for (int m = 0; m < 4; ++m) {
    const int rl = mt * 128 + wm * 64 + m * 16 + l15;
    unsigned char* yp = (unsigned char*)P.Y + ((size_t)be * 512 + rl) * 1024 + nt * 256 + wn * 64 + quad * 4;
#pragma unroll
    for (int n = 0; n < 4; ++n) {
      int pk_ = 0;
      pk_ = __builtin_amdgcn_cvt_pk_fp8_f32(acc[m][n][0], acc[m][n][1], pk_, false);
      pk_ = __builtin_amdgcn_cvt_pk_fp8_f32(acc[m][n][2], acc[m][n][3], pk_, true);
      *(unsigned*)(yp + n * 16) = (unsigned)pk_;
    }
  }
}

__device__ void convin_unit(const Params& P, char* lds, int u) {
  GEMM_PRE();
  const int mt = u / 12, nt = u % 12;
  const bf16_t* Wt = P.wt_cin + (size_t)nt * 256 * 1024;
  gemm_mainloop(lds, P.H + (size_t)(mt * 128 + lr) * 1024 + lc, P.H + (size_t)(mt * 128 + 64 + lr) * 1024 + lc, Wt + (size_t)lr * 1024 + lc, 1024, 1024, acc);
#pragma unroll
  for (int m = 0; m < 4; ++m) {
    const int t = mt * 128 + wm * 64 + m * 16 + l15;
    if (nt < 8) {
      bf16_t* dp = P.Zc + (size_t)t * 1024 + nt * 128 + wn * 32 + quad * 4;
      store4_bf16(dp, acc[m][0] * acc[m][1]);
      store4_bf16(dp + 16, acc[m][2] * acc[m][3]);
    } else {
      bf16_t* dp = P.BG + (size_t)t * 1024 + (nt - 8) * 256 + wn * 64 + quad * 4;
#pragma unroll
      for (int n = 0; n < 4; ++n) store4_bf16(dp + n * 16, acc[m][n]);
    }
  }
}

__device__ void attn_unit(const Params& P, char* lds, int u) {
  const int tid = otid(), lane = tid & 63, wave = tid >> 6, l15 = lane & 15, quad = lane >> 4;
  const int qg = wave & 3, sm = wave >> 2;
  const int qblk = u & 31, h = (u >> 5) % 6, b = u / 192;
  const int q0 = qblk * 128 + qg * 32;
  float lam;
  {
    const float a = wave_sum(P.lam_q1[lane] * P.lam_k1[lane]), c = wave_sum(P.lam_q2[lane] * P.lam_k2[lane]);
    lam = __expf(a) - __expf(c) + 0.2f;
  }
  float negM;
  {
    float gq = fabsf(P.q_norm[lane]), gk = fabsf(P.k_norm[lane]);
#pragma unroll
    for (int o_ = 32; o_ > 0; o_ >>= 1) { gq = fmaxf(gq, __shfl_xor(gq, o_)); gk = fmaxf(gk, __shfl_xor(gk, o_)); }
    negM = -(gq * gk * (8.f * 1.44269504f) * 1.02f + 0.5f);
  }
  bf16x8 qf[2][2];
#pragma unroll
  for (int qb = 0; qb < 2; ++qb)
#pragma unroll
    for (int ds = 0; ds < 2; ++ds)
      qf[qb][ds] = *(const bf16x8*)(P.Q + (size_t)(b * 4096 + q0 + qb * 16 + l15) * 768 + h * 128 + sm * 64 + ds * 32 + quad * 8);
  f32x4 o[8][2];
#pragma unroll
  for (int eb = 0; eb < 8; ++eb) { o[eb][0] = (f32x4){0.f, 0.f, 0.f, 0.f}; o[eb][1] = (f32x4){0.f, 0.f, 0.f, 0.f}; }
  f32x4 lsum[2] = {(f32x4){0.f, 0.f, 0.f, 0.f}, (f32x4){0.f, 0.f, 0.f, 0.f}};
  const bf16x8 ones8 = {(short)0x3F80, (short)0x3F80, (short)0x3F80, (short)0x3F80, (short)0x3F80, (short)0x3F80, (short)0x3F80, (short)0x3F80};
  const int kkey = tid >> 3, gch = (tid & 7) ^ ((tid >> 4) & 7);
  const bf16_t* kp0 = P.Kb + ((size_t)b * 4352 + kkey) * 768 + h * 128 + gch * 8;
  const bf16_t* vp0 = P.Vt + ((size_t)b * 768 + h * 128 + kkey) * 4352 + gch * 8;
  const bf16_t* vp1 = vp0 + (size_t)64 * 4352;
  char* lw = lds + __builtin_amdgcn_readfirstlane(wave) * 1024;
  glds16(kp0, lw); glds16(kp0 + 64, lw + 8192); glds16(vp0, lw + 16384); glds16(vp1, lw + 24576);
  __syncthreads();
  const int NT = 68;
  int koff[2], voff[2][2];
#pragma unroll
  for (int ds = 0; ds < 2; ++ds) koff[ds] = l15 * 128 + (((ds * 4 + quad) ^ ((l15 >> 1) & 7)) * 16);
#pragma unroll
  for (int ks = 0; ks < 2; ++ks) {
    const int c0 = ks * 4 + (quad >> 1), c1 = c0 + 2, wi = (quad & 1) * 8;
    voff[ks][0] = l15 * 128 + ((c0 ^ (l15 & 7)) * 16) + wi;
    voff[ks][1] = l15 * 128 + ((c1 ^ (l15 & 7)) * 16) + wi;
  }
  for (int kt = 0; kt < NT; ++kt) {
    const int cur = kt & 1;
    const bool more = kt + 1 < NT;
    if (more) {
      const size_t ko = (size_t)(kt + 1) * 64 * 768;
      char* nb = lw + (cur ^ 1) * 32768;
      glds16(kp0 + ko, nb); glds16(kp0 + ko + 64, nb + 8192); glds16(vp0 + (kt + 1) * 64, nb + 16384); glds16(vp1 + (kt + 1) * 64, nb + 24576);
    }
    const char* Ks = lds + cur * 32768 + sm * 8192;
    const char* Vs = lds + cur * 32768 + 16384;
    f32x4 s[4][2];
#pragma unroll
    for (int kb = 0; kb < 4; ++kb) { s[kb][0] = (f32x4){negM, negM, negM, negM}; s[kb][1] = (f32x4){negM, negM, negM, negM}; }
#pragma unroll
    for (int kb = 0; kb < 4; ++kb)
#pragma unroll
      for (int ds = 0; ds < 2; ++ds) {
        const bf16x8 kf = *(const bf16x8*)(Ks + koff[ds] + kb * 2048);
        s[kb][0] = mfma16(kf, qf[0][ds], s[kb][0]);
        s[kb][1] = mfma16(kf, qf[1][ds], s[kb][1]);
      }
    bf16x8 pf[2][2];
    __builtin_amdgcn_sched_barrier(0);
#pragma unroll
    for (int qb = 0; qb < 2; ++qb) {
#pragma unroll
      for (int kb = 0; kb < 4; ++kb)
#pragma unroll
        for (int r = 0; r < 4; ++r) s[kb][qb][r] = __builtin_amdgcn_exp2f(s[kb][qb][r]);
#pragma unroll
      for (int ks = 0; ks < 2; ++ks) {
        u32x4 w;
        w.x = pk_bf16(s[2 * ks][qb][0], s[2 * ks][qb][1]); w.y = pk_bf16(s[2 * ks][qb][2], s[2 * ks][qb][3]);
        w.z = pk_bf16(s[2 * ks + 1][qb][0], s[2 * ks + 1][qb][1]); w.w = pk_bf16(s[2 * ks + 1][qb][2], s[2 * ks + 1][qb][3]);
        pf[qb][ks] = __builtin_bit_cast(bf16x8, w);
      }
    }
    __builtin_amdgcn_sched_barrier(0);
#pragma unroll
    for (int ks = 0; ks < 2; ++ks) { lsum[0] = mfma16(ones8, pf[0][ks], lsum[0]); lsum[1] = mfma16(ones8, pf[1][ks], lsum[1]); }
#pragma unroll
    for (int eb = 0; eb < 8; ++eb)
#pragma unroll
      for (int ks = 0; ks < 2; ++ks) {
        const bf16x8 vf = *(const bf16x8*)(Vs + koff[ks] + eb * 2048);
        o[eb][0] = mfma16(vf, pf[0][ks], o[eb][0]);
        o[eb][1] = mfma16(vf, pf[1][ks], o[eb][1]);
        if (ks == 1 && (eb & 1)) __builtin_amdgcn_sched_barrier(0);
      }
    __builtin_amdgcn_sched_barrier(0);
    __syncthreads();
  }
#pragma unroll
  for (int qb = 0; qb < 2; ++qb) {
    const float inv = 1.f / lsum[qb][0];
#pragma unroll
    for (int eb = 0; eb < 8; ++eb) o[eb][qb] *= inv;
  }
  float* comb = (float*)lds;
  if (sm == 1) {
#pragma unroll
    for (int eb = 0; eb < 8; ++eb)
#pragma unroll
      for (int qb = 0; qb < 2; ++qb)
#pragma unroll
        for (int r = 0; r < 4; ++r) comb[(qg * 64 + eb * 8 + qb * 4 + r) * 64 + lane] = o[eb][qb][r];
  }
  __syncthreads();
  if (sm == 0) {
#pragma unroll
    for (int qb = 0; qb < 2; ++qb) {
      float ss = 0.f;
#pragma unroll
      for (int eb = 0; eb < 8; ++eb)
#pragma unroll
        for (int r = 0; r < 4; ++r) { const float v = o[eb][qb][r] - lam * comb[(qg * 64 + eb * 8 + qb * 4 + r) * 64 + lane]; o[eb][qb][r] = v; ss += v * v; }
      ss += __shfl_xor(ss, 16); ss += __shfl_xor(ss, 32);
      const float rinv = rsqrtf(ss * (1.f / 128.f) + EPSV) * 0.8f;
      bf16_t* dp = P.OCAT + (size_t)(b * 4096 + q0 + qb * 16 + l15) * 1024 + h * 128 + quad * 4;
#pragma unroll
      for (int eb = 0; eb < 8; ++eb) {
        const f32x4 g = *(const f32x4*)(P.subln + eb * 16 + quad * 4);
        store4_bf16(dp + eb * 16, o[eb][qb] * rinv * g);
      }
    }
  }
}


#define XB_TMO      128
#define XB_XCNT(j)  (256  + 64 * (j))
#define XB_XSUB(j)  (1280 + 64 * (j))
#define XB_XGEN(j)  (2304 + 64 * (j))
#define XB_TOP      3328
#define XB_TOPGEN   3392
#define XCD_BAR_WORDS 3456
#define XB_SPIN_CAP (1u << 18)
#define LAS __attribute__((address_space(3)))
__device__ __forceinline__ unsigned xb_ld(unsigned* p)              { return __hip_atomic_load(p, __ATOMIC_RELAXED, __HIP_MEMORY_SCOPE_AGENT); }
__device__ __forceinline__ unsigned xb_add(unsigned* p, unsigned v) { return __hip_atomic_fetch_add(p, v, __ATOMIC_RELAXED, __HIP_MEMORY_SCOPE_AGENT); }
__device__ __forceinline__ unsigned xb_xcc_id() { return (unsigned)__builtin_amdgcn_s_getreg((3 << 11) | 20) & 0xFu; }
#define XB_SPIN(cond, bar) do { unsigned _sp = 0; while (cond) { __builtin_amdgcn_s_sleep(1); \
    if ((++_sp & 255u) == 0u) { if (xb_ld(&(bar)[XB_TMO])) break; if (_sp > XB_SPIN_CAP) { atomicAdd(&(bar)[XB_TMO], 1u); break; } } } } while (0)
struct XcdBarrier { unsigned* bar; unsigned x; volatile LAS unsigned* st; };
__device__ __forceinline__ XcdBarrier xcd_barrier_post(unsigned* bar, volatile LAS unsigned* st) {
    XcdBarrier b; b.bar = bar; b.x = xb_xcc_id(); b.st = st;
    if (threadIdx.x == 0) (void)xb_add(&bar[XB_XCNT(b.x)], 1u);
    return b;
}
__device__ __forceinline__ void xcd_barrier_complete(unsigned* bar, unsigned x, unsigned& nloc, unsigned& nx) {
    const unsigned G = gridDim.x * gridDim.y * gridDim.z;
    unsigned sum, cnt, mine, sp = 0u;
    for (;;) {
        sum = 0u; cnt = 0u; mine = 0u;
#pragma unroll
        for (unsigned j = 0; j < 16; ++j) { const unsigned c = xb_ld(&bar[XB_XCNT(j)]); sum += c; cnt += (c > 0u) ? 1u : 0u; mine = (j == x) ? c : mine; }
        if (sum == G) break;
        __builtin_amdgcn_s_sleep(1);
        if ((++sp & 255u) == 0u) { if (xb_ld(&bar[XB_TMO])) break; if (sp > XB_SPIN_CAP) { atomicAdd(&bar[XB_TMO], 1u); break; } }
    }
    nloc = mine > 0u ? mine : 1u; nx = cnt > 0u ? cnt : 1u;
}
__device__ __forceinline__ void xcd_barrier(const XcdBarrier& b) {
    asm volatile("s_waitcnt vmcnt(0)" ::: "memory");
    __syncthreads();
    if (threadIdx.x == 0) {
        unsigned* bar = b.bar;
        __builtin_amdgcn_s_waitcnt(0);
        unsigned nloc = b.st[0], nx = b.st[1];
        if (nloc == 0u) { xcd_barrier_complete(bar, b.x, nloc, nx); b.st[0] = nloc; b.st[1] = nx; }
        const unsigned old = xb_add(&bar[XB_XSUB(b.x)], 1u);
        const unsigned gen = old / nloc;
        if (old + 1u == (gen + 1u) * nloc) {
            __builtin_amdgcn_fence(__ATOMIC_RELEASE, "agent");
            asm volatile("s_waitcnt vmcnt(0)" ::: "memory");
            const unsigned og = xb_add(&bar[XB_TOP], 1u);
            const unsigned tg = og / nx;
            if (og + 1u == (tg + 1u) * nx) xb_add(&bar[XB_TOPGEN], 1u);
            else XB_SPIN(xb_ld(&bar[XB_TOPGEN]) == tg, bar);
            __builtin_amdgcn_fence(__ATOMIC_ACQUIRE, "agent");
            xb_add(&bar[XB_XGEN(b.x)], 1u);
            asm volatile("s_waitcnt vmcnt(0)" ::: "memory");
        } else {
            XB_SPIN(xb_ld(&bar[XB_XGEN(b.x)]) == gen, bar);
            __builtin_amdgcn_fence(__ATOMIC_ACQUIRE, "agent");
            asm volatile("s_waitcnt vmcnt(0)" ::: "memory");
        }
    }
    __syncthreads();
}

__global__ void __launch_bounds__(NTHREADS) fwd_megakernel(Params P) {
  extern __shared__ __attribute__((aligned(16))) char lds[];
  int* s_unit_p = (int*)(lds + LDS_BYTES);
  int u;
  volatile LAS unsigned* xst = (volatile LAS unsigned*)(lds + LDS_BYTES + 16);
  if (threadIdx.x == 0) { xst[0] = 0u; xst[1] = 0u; }
  __syncthreads();
  const XcdBarrier xb = xcd_barrier_post(P.counters, xst);
#define PHASE_BEGIN(k) if (P.phase_lo <= (k) && (k) < P.phase_hi) { if ((k) > P.phase_lo) xcd_barrier(xb); unsigned* ctr = P.counters + (k); (void)ctr;
#define PHASE_END }
  const int ubase = (int)((blockIdx.x & 7u) * (gridDim.x >> 3) + (blockIdx.x >> 3));
#define FOR_UNITS(N) for (u = ubase; u < (N); u += gridDim.x)
#define USYNC __syncthreads();
  PHASE_BEGIN(0)
    FOR_UNITS(P0_GEMV + P0_DFT + P0_FOLD + P0_ROPE) {
      USYNC
      if (u < P0_GEMV) p0_gemv(P, lds, u);
      else if (u < P0_GEMV + P0_DFT) p0_dft(P, lds, u - P0_GEMV);
      else if (u < P0_GEMV + P0_DFT + P0_FOLD) p0_fold(P, lds, u - P0_GEMV - P0_DFT);
      else p0_rope(P);
    }
    USYNC
    cvt_stream(P, lds, u - (P0_GEMV + P0_DFT + P0_FOLD + P0_ROPE), (int)gridDim.x, P0_CVT);
  PHASE_END
  PHASE_BEGIN(1) for (int rep = 0; rep < DBG_REPS; ++rep) phase_modulate(P, P.x, 0, true, -1); PHASE_END
  PHASE_BEGIN(2)
    int q_;
    while ((q_ = next_unit(ctr, s_unit_p)) < 324 + 48 * 41) {
      if (q_ < 324) u = q_;
      else {
        const int t_ = q_ - 324, cyc_ = t_ / 41, i_ = t_ % 41, cb_ = (i_ * 16) / 41;
        if (((i_ + 1) * 16) / 41 > cb_) {
          const int cg_ = cyc_ * 16 + cb_;
          cvt_stream(P, lds, CVT_SMALL + cg_ * 4, 1, CVT_SMALL + cg_ * 4 + 4);
          continue;
        }
        u = 324 + cyc_ * 25 + (i_ - cb_);
      }
      if (u >= 256 && u < 324) {
        const int bb = (u < 260) ? (u - 256) : ((u - 260) >> 4);
        if (threadIdx.x == 0) {
          unsigned sp_ = 0;
          while (xb_ld(&P.counters[32 + bb]) < 64u) { __builtin_amdgcn_s_sleep(2); if (++sp_ > (1u << 22)) break; }
          __builtin_amdgcn_fence(__ATOMIC_ACQUIRE, "agent");
          asm volatile("s_waitcnt vmcnt(0)" ::: "memory");
        }
        __syncthreads();
        if (u < 260) dft_nyquist_unit(P, u - 256); else dft_unit(P, lds, u - 260);
      } else {
        const int ou = (u < 256) ? (1152 + u) : (u < 1092) ? (u - 324) : (u < 1476) ? (768 + (u - 1092)) : (1408 + (u - 1476));
        inproj_unit(P, lds, ou);
        if (u < 256) {
          asm volatile("s_waitcnt vmcnt(0)" ::: "memory");
          __syncthreads();
          if (threadIdx.x == 0) {
            __builtin_amdgcn_fence(__ATOMIC_RELEASE, "agent");
            asm volatile("s_waitcnt vmcnt(0)" ::: "memory");
            xb_add(&P.counters[32 + ((u & 63) >> 4)], 1u);
          }
        }
      }
    }
  PHASE_END
  PHASE_BEGIN(3) FOR_UNITS(768) { USYNC attn_unit(P, lds, u); } PHASE_END
  PHASE_BEGIN(4) for (int rep = 0; rep < DBG_REPG; ++rep) FOR_UNITS(512) { USYNC outproj_unit(P, lds, u, P.wt_out0, P.x, 0); } PHASE_END
  PHASE_BEGIN(5) for (int rep = 0; rep < DBG_REP5; ++rep) phase_router(P, lds, 0); PHASE_END
#define TOPK_AND_CVT(first, count) do { if (ubase < 64) { FOR_UNITS(64) { USYNC topk_unit(P, lds, u); } } \
    else { USYNC cvt_stream(P, lds, CVT_SMALL + CVT_MOE_PER_LAYER + (first) + (ubase - 64), (int)gridDim.x - 64, CVT_SMALL + CVT_MOE_PER_LAYER + (first) + (count)); } } while (0)
  PHASE_BEGIN(6) TOPK_AND_CVT(0, CVT_MOE_PER_LAYER / 2); PHASE_END
  PHASE_BEGIN(7) for (int rep = 0; rep < DBG_REP7; ++rep) FOR_UNITS(2048) { USYNC moe_gu_unit(P, lds, u, 0); } PHASE_END
  PHASE_BEGIN(8) for (int rep = 0; rep < DBG_REPD; ++rep) FOR_UNITS(1024) { USYNC moe_down_unit(P, lds, u, 0); } PHASE_END
  PHASE_BEGIN(9) phase_modulate(P, P.out, 1, false, 0); PHASE_END
  PHASE_BEGIN(10) for (int rep = 0; rep < DBG_REPG; ++rep) FOR_UNITS(1536) { USYNC convin_unit(P, lds, u); } PHASE_END
  PHASE_BEGIN(11) for (int rep = 0; rep < DBG_REPS; ++rep) phase_conv(P); PHASE_END
  PHASE_BEGIN(12) FOR_UNITS(512) { USYNC outproj_unit(P, lds, u, P.wt_cout, (const float*)nullptr, 1); } PHASE_END
  PHASE_BEGIN(13) for (int rep = 0; rep < DBG_REP5; ++rep) phase_router(P, lds, 1); PHASE_END
  PHASE_BEGIN(14) TOPK_AND_CVT(CVT_MOE_PER_LAYER / 2, CVT_MOE_PER_LAYER - CVT_MOE_PER_LAYER / 2); PHASE_END
  PHASE_BEGIN(15) FOR_UNITS(2048) { USYNC moe_gu_unit(P, lds, u, 1); } PHASE_END
  PHASE_BEGIN(16) for (int rep = 0; rep < DBG_REPD; ++rep) FOR_UNITS(1024) { USYNC moe_down_unit(P, lds, u, 1); } PHASE_END
  PHASE_BEGIN(17) phase_combine(P, 1); PHASE_END
}

extern "C" void kernel_launch(void* const* d_in, const int* in_sizes, int n_in, void* d_out, int out_size, void* d_ws, size_t ws_size, hipStream_t stream) {
  (void)in_sizes; (void)n_in; (void)out_size; (void)ws_size;
  static int grid_blocks = 0;
  if (!grid_blocks) {
    int dev = 0, cus = 0, per_cu = 0;
    hipGetDevice(&dev);
    hipDeviceGetAttribute(&cus, hipDeviceAttributeMultiprocessorCount, dev);
    if (hipFuncSetAttribute((const void*)fwd_megakernel, hipFuncAttributeMaxDynamicSharedMemorySize, LDS_TOTAL) != hipSuccess) fprintf(stderr, "hipFuncSetAttribute failed\n");
    hipOccupancyMaxActiveBlocksPerMultiprocessor(&per_cu, (const void*)fwd_megakernel, NTHREADS, LDS_TOTAL);
    if (per_cu < 1) per_cu = 1;
    grid_blocks = cus * per_cu;
  }
  Params p{};
  const float* const* in = (const float* const*)d_in;
  p.x = in[0]; p.c = in[1]; p.ctx = in[2]; p.c_ctx = in[3]; p.ada_w = in[4]; p.ada_b = in[5]; p.norm_mix = in[6]; p.norm_ffn = in[7];
  p.attn_w_in = in[8]; p.q_norm = in[9]; p.k_norm = in[10]; p.lam_q1 = in[11]; p.lam_k1 = in[12]; p.lam_q2 = in[13]; p.lam_k2 = in[14];
  p.subln = in[15]; p.attn_w_out = in[16]; p.conv_w_in = in[17]; p.conv_w = in[18]; p.conv_w_out = in[19]; p.router_w = in[20];
  p.moe_gate = in[21]; p.moe_up = in[22]; p.moe_down = in[23];
  p.out = (float*)d_out;
  char* w = (char*)d_ws;
  size_t off = 0;
  auto take = [&](size_t bytes) { char* r = w + off; off += (bytes + 255) & ~(size_t)255; return r; };
  p.counters = (unsigned*)take(XCD_BAR_WORDS * 4);
  p.mods = (float*)take((size_t)2 * 5 * 6144 * 4);
  p.rope = (float*)take(2048 * 4);
  p.aff = (float*)take((size_t)64 * 4096 * 4);
  p.gate = (float*)take((size_t)64 * 512 * 4);
  p.idx = (int*)take((size_t)64 * 512 * 4);
  p.inv = (int*)take((size_t)16384 * 16 * 4);
  p.wt_in0 = (bf16_t*)take((size_t)2816 * 1024 * 2);
  p.wt_out0 = (bf16_t*)take((size_t)1024 * 1024 * 2);
  p.wt_cin = (bf16_t*)take((size_t)3072 * 1024 * 2);
  p.wt_cout = (bf16_t*)take((size_t)1024 * 1024 * 2);
  p.wt_gu = (bf16_t*)take((size_t)32 * 2048 * 1024 * 2);
  p.wt_d = (bf16_t*)take((size_t)32 * 1024 * 1024 * 2);
  p.dft = (bf16_t*)take((size_t)4096 * 8192 * 2);
  p.XB = (bf16_t*)take((size_t)16384 * 1024 * 2);
  p.Y = p.dft;
  p.H = (bf16_t*)take((size_t)16384 * 1024 * 2);
  p.HC = (bf16_t*)take((size_t)1024 * 1024 * 2);
  p.OCAT = (bf16_t*)take((size_t)16384 * 1024 * 2);
  p.A2 = (bf16_t*)take((size_t)64 * 512 * 1024 * 2);
  char* l0 = take((size_t)16384 * 768 * 2 + (size_t)4 * 4352 * 768 * 2 * 2 + (size_t)4 * 256 * 8192 * 2);
  p.Q = (bf16_t*)l0;
  p.Kb = (bf16_t*)(l0 + (size_t)16384 * 768 * 2);
  p.Vt = (bf16_t*)(l0 + (size_t)16384 * 768 * 2 + (size_t)4 * 4352 * 768 * 2);
  p.Zt = (bf16_t*)(l0 + (size_t)16384 * 768 * 2 + (size_t)4 * 4352 * 768 * 2 * 2);
  p.Zc = (bf16_t*)l0;
  p.BG = (bf16_t*)(l0 + (size_t)16384 * 1024 * 2);
  hipMemsetAsync(p.counters, 0, XCD_BAR_WORDS * 4, stream);
#if SINGLE_LAUNCH
  p.phase_lo = 0; p.phase_hi = DBG_PHASE_HI;
  void* args[] = {&p};
  hipError_t e = hipLaunchCooperativeKernel((void*)fwd_megakernel, dim3(grid_blocks), dim3(NTHREADS), args, LDS_TOTAL, stream);
  if (e != hipSuccess) fprintf(stderr, "cooperative launch failed: %s (grid %d)\n", hipGetErrorString(e), grid_blocks);
#else
  for (int ph = 0; ph < NPHASES; ++ph) {
    p.phase_lo = ph; p.phase_hi = ph + 1;
    fwd_megakernel<<<dim3(grid_blocks), dim3(NTHREADS), LDS_TOTAL, stream>>>(p);
  }
#endif
}
```
